# Optimizing an MI355X kernel written in HIP

```python
import math
import jax
import jax.numpy as jnp
from jax import lax
import numpy as np

D_MODEL = 1024
BATCH = 8
SEQ = 2048
DEPTH = 1
DEC_BATCH = 128
DEC_SEQ = 8
PAST_LEN = 16384
PAGE_SIZE = 128

MIX_WIDTH = 2 * D_MODEL
SSD_WIDTH = MIX_WIDTH // 2
RWKV_WIDTH = MIX_WIDTH - SSD_WIDTH
SSD_HEAD_DIM = 64
SSD_HEADS = SSD_WIDTH // SSD_HEAD_DIM
SSD_GROUPS = 2
SSD_HPG = SSD_HEADS // SSD_GROUPS
SSD_STATE = 128
SSD_CONV = 4
SSD_CHUNK = 128
SSD_CONV_DIM = SSD_WIDTH + 2 * SSD_GROUPS * SSD_STATE
RWKV_HEAD_DIM = 64
RWKV_HEADS = RWKV_WIDTH // RWKV_HEAD_DIM
DECAY_LORA = 64
AAA_LORA = 64
GATE_LORA = 128
RWKV_PROJ = 3 * RWKV_WIDTH + DECAY_LORA + AAA_LORA + GATE_LORA
IN_PROJ = SSD_WIDTH + SSD_CONV_DIM + SSD_HEADS + RWKV_PROJ
IN_SPLITS = (SSD_WIDTH, SSD_WIDTH + SSD_CONV_DIM, SSD_WIDTH + SSD_CONV_DIM + SSD_HEADS)
XBC_SPLITS = (SSD_WIDTH, SSD_WIDTH + SSD_GROUPS * SSD_STATE)
RWKV_SPLITS = (RWKV_WIDTH, 2 * RWKV_WIDTH, 3 * RWKV_WIDTH, 3 * RWKV_WIDTH + DECAY_LORA,
               3 * RWKV_WIDTH + DECAY_LORA + AAA_LORA)
D_FF = -(-8 * D_MODEL // (3 * 256)) * 256
PLE_DIM = 256
NORM_EPS = 1e-6
GN_EPS = 64e-5

kernel_name = 'hymba_ssd_rwkv7_ple_step'


def rmsnorm(x, g):
    xf = x.astype(jnp.float32)
    y = xf * lax.rsqrt(jnp.mean(xf * xf, axis=-1, keepdims=True) + NORM_EPS)
    return (y * g.astype(jnp.float32)).astype(x.dtype)


def ssd_chunked(x, dt, a_head, bm, cm, h0):
    b, l, g, e, p = x.shape
    n = bm.shape[-1]
    q = SSD_CHUNK if l % SSD_CHUNK == 0 else l
    c = l // q
    f32 = jnp.float32
    x = x.astype(f32).reshape(b, c, q, g, e, p)
    dt = dt.astype(f32).reshape(b, c, q, g, e)
    bm = bm.astype(f32).reshape(b, c, q, g, n)
    cm = cm.astype(f32).reshape(b, c, q, g, n)
    a_cum = jnp.cumsum(dt * a_head.astype(f32), axis=2)
    seg = a_cum[:, :, :, None] - a_cum[:, :, None, :]
    causal = jnp.tril(jnp.ones((q, q), dtype=bool))[None, None, :, :, None, None]
    decay_qs = jnp.exp(jnp.where(causal, seg, -jnp.inf))
    cb = jnp.einsum('bcqgn,bcsgn->bcqsg', cm, bm)
    w_qs = cb[..., None] * decay_qs * dt[:, :, None]
    y_diag = jnp.einsum('bcqsge,bcsgep->bcqgep', w_qs, x)
    decay_end = jnp.exp(a_cum[:, :, -1:] - a_cum) * dt
    chunk_states = jnp.einsum('bcsgn,bcsge,bcsgep->bcgepn', bm, decay_end, x)
    chunk_decay = jnp.exp(a_cum[:, :, -1])

    def step(h, inp):
        s_c, d_c = inp
        return h * d_c[..., None, None] + s_c, h

    h_fin, h_in = lax.scan(step, h0.astype(f32),
                           (jnp.moveaxis(chunk_states, 1, 0), jnp.moveaxis(chunk_decay, 1, 0)))
    h_in = jnp.moveaxis(h_in, 0, 1)
    y_off = jnp.einsum('bcqgn,bcgepn->bcqgep', cm, h_in) * jnp.exp(a_cum)[..., None]
    return (y_diag + y_off).reshape(b, l, g, e, p), h_fin


def wkv_scan(r, decay, k, v, kk, a, s0):
    f32 = jnp.float32
    seq = tuple(jnp.moveaxis(t.astype(f32), 1, 0) for t in (r, decay, k, v, kk, a))

    def step(s, inp):
        r_t, w_t, k_t, v_t, kk_t, a_t = inp
        s_kk = jnp.einsum('bhvk,bhk->bhv', s, kk_t)
        s = (s * w_t[:, :, None, :] - s_kk[..., None] * (kk_t * a_t)[:, :, None, :]
             + v_t[..., None] * k_t[:, :, None, :])
        return s, jnp.einsum('bhvk,bhk->bhv', s, r_t)

    s_fin, out = lax.scan(step, s0.astype(f32), seq)
    return jnp.moveaxis(out, 0, 1), s_fin


def token_mixers(hn, conv_buf, shift_buf, ssm0, wkv0, w):
    b, l, _ = hn.shape
    dtype = hn.dtype
    f32 = jnp.float32
    proj = hn @ w['w_in']
    z, xbc, dt_raw, rw = jnp.split(proj, IN_SPLITS, axis=-1)

    xbc_full = jnp.concatenate([conv_buf.astype(xbc.dtype), xbc], axis=1)
    conv = lax.conv_general_dilated(
        xbc_full, w['conv_w'][:, None, :].astype(xbc.dtype), (1,), 'VALID',
        dimension_numbers=('NWC', 'WIO', 'NWC'), feature_group_count=SSD_CONV_DIM) + w['conv_b'].astype(xbc.dtype)
    conv_new = xbc_full[:, -(SSD_CONV - 1):]
    xbc_act = jax.nn.silu(conv)
    xs, bm, cm = jnp.split(xbc_act, XBC_SPLITS, axis=-1)
    xs = xs.reshape(b, l, SSD_GROUPS, SSD_HPG, SSD_HEAD_DIM)
    bm = bm.reshape(b, l, SSD_GROUPS, SSD_STATE)
    cm = cm.reshape(b, l, SSD_GROUPS, SSD_STATE)
    dt = jax.nn.softplus(dt_raw.astype(f32) + w['dt_bias'].astype(f32)).reshape(b, l, SSD_GROUPS, SSD_HPG)
    a_head = -jnp.exp(w['a_log'].astype(f32)).reshape(SSD_GROUPS, SSD_HPG)
    y, ssm_fin = ssd_chunked(xs, dt, a_head, bm, cm,
                             ssm0.reshape(b, SSD_GROUPS, SSD_HPG, SSD_HEAD_DIM, SSD_STATE))
    y = y + w['d_skip'].astype(f32).reshape(SSD_GROUPS, SSD_HPG, 1) * xs.astype(f32)
    yg = (y.reshape(b, l, SSD_WIDTH) * jax.nn.silu(z.astype(f32))).reshape(b, l, SSD_GROUPS, SSD_WIDTH // SSD_GROUPS)
    yg = yg * lax.rsqrt(jnp.mean(yg * yg, axis=-1, keepdims=True) + NORM_EPS)
    y_ssd = yg.reshape(b, l, SSD_WIDTH) * w['ssd_norm'].astype(f32)

    prev = jnp.concatenate([shift_buf.astype(rw.dtype), rw], axis=1)[:, :-1]
    shift_new = rw[:, -1:]
    u = rw + (prev - rw) * w['shift_mu']
    r, k, v, w_lo, a_lo, g_lo = jnp.split(u, RWKV_SPLITS, axis=-1)
    w_log = -jax.nn.softplus(-(w['w0'] + jnp.tanh(w_lo) @ w['w2']).astype(f32)) - 0.5
    decay = jnp.exp(-jnp.exp(w_log))
    a = jax.nn.sigmoid((w['a0'] + a_lo @ w['a2']).astype(f32))
    gate = (jax.nn.sigmoid(g_lo) @ w['g2']).astype(f32)

    def heads(t):
        return t.reshape(b, l, RWKV_HEADS, RWKV_HEAD_DIM)

    kk = heads((k * w['k_k']).astype(f32))
    kk = kk / jnp.maximum(jnp.sqrt(jnp.sum(kk * kk, axis=-1, keepdims=True)), 1e-12)
    k = k.astype(f32) * (1.0 + (a - 1.0) * w['k_a'].astype(f32))
    rh, kh, vh = heads(r.astype(f32)), heads(k), heads(v.astype(f32))
    o, wkv_fin = wkv_scan(rh, heads(decay), kh, vh, kk, heads(a), wkv0)
    mu = jnp.mean(o, axis=-1, keepdims=True)
    var = jnp.mean(jnp.square(o - mu), axis=-1, keepdims=True)
    on = ((o - mu) * lax.rsqrt(var + GN_EPS)).reshape(b, l, RWKV_WIDTH)
    on = on * w['ln_x_w'].astype(f32) + w['ln_x_b'].astype(f32)
    r_k = w['r_k'].astype(f32).reshape(RWKV_HEADS, RWKV_HEAD_DIM)
    bonus = jnp.sum(rh * kh * r_k, axis=-1, keepdims=True) * vh
    y_rwkv = (on + bonus.reshape(b, l, RWKV_WIDTH)) * gate

    out = jnp.concatenate([y_ssd, y_rwkv], axis=-1).astype(dtype) @ w['w_out']
    ssm_new = ssm_fin.reshape(b, SSD_HEADS, SSD_HEAD_DIM, SSD_STATE).astype(dtype)
    return out, conv_new.astype(dtype), shift_new.astype(dtype), ssm_new, wkv_fin.astype(dtype)


def layer(h, p, conv_buf, shift_buf, ssm0, wkv0, w):
    mix, conv_new, shift_new, ssm_new, wkv_new = token_mixers(
        rmsnorm(h, w['norm_mix']), conv_buf, shift_buf, ssm0, wkv0, w)
    h = h + mix
    hf = rmsnorm(h, w['norm_ffn'])
    h = h + (jax.nn.silu(hf @ w['w_gate']) * (hf @ w['w_up'])) @ w['w_down']
    gate = jax.nn.sigmoid(rmsnorm(h, w['norm_ple']) @ w['w_ple_gate'])
    h = h + gate * (p.astype(h.dtype) @ w['w_ple_proj'])
    return h, ssm_new, conv_new, wkv_new, shift_new


def setup_inputs(seed: int = 0) -> dict:
    key = jax.random.key(seed)
    ks = list(jax.random.split(key, 40))

    def nrm(shape, scale):
        return scale * jax.random.normal(ks.pop(), shape, jnp.float32)

    def unif(shape, lo, hi):
        return jax.random.uniform(ks.pop(), shape, jnp.float32, lo, hi)

    L = (DEPTH,)
    dt0 = jnp.exp(unif(L + (SSD_HEADS,), math.log(1e-3), math.log(1e-1)))
    return {
        'x_prompt': nrm((BATCH, SEQ, D_MODEL), 1.0),
        'x_sample': nrm((DEC_BATCH, DEC_SEQ, D_MODEL), 1.0),
        'state_ssm': nrm(L + (DEC_BATCH, SSD_HEADS, SSD_HEAD_DIM, SSD_STATE), 0.1),
        'state_conv': nrm(L + (DEC_BATCH, SSD_CONV - 1, SSD_CONV_DIM), 1.0),
        'state_wkv': nrm(L + (DEC_BATCH, RWKV_HEADS, RWKV_HEAD_DIM, RWKV_HEAD_DIM), 0.1),
        'state_shift': nrm(L + (DEC_BATCH, 1, RWKV_PROJ), 1.0),
        'p_prompt': nrm((DEPTH, BATCH, SEQ, PLE_DIM), 1.0),
        'p_sample': nrm((DEPTH, DEC_BATCH, DEC_SEQ, PLE_DIM), 1.0),
        'norm_mix': 1.0 + nrm(L + (D_MODEL,), 0.05),
        'w_in': nrm(L + (D_MODEL, IN_PROJ), D_MODEL ** -0.5),
        'conv_w': nrm(L + (SSD_CONV, SSD_CONV_DIM), SSD_CONV ** -0.5),
        'conv_b': nrm(L + (SSD_CONV_DIM,), 0.01),
        'dt_bias': dt0 + jnp.log(-jnp.expm1(-dt0)),
        'a_log': jnp.log(unif(L + (SSD_HEADS,), 1.0, 16.0)),
        'd_skip': 1.0 + nrm(L + (SSD_HEADS,), 0.1),
        'ssd_norm': 1.0 + nrm(L + (SSD_WIDTH,), 0.05),
        'shift_mu': unif(L + (RWKV_PROJ,), 0.0, 1.0),
        'w0': -2.5 + nrm(L + (RWKV_WIDTH,), 0.5),
        'w2': nrm(L + (DECAY_LORA, RWKV_WIDTH), 0.1 * DECAY_LORA ** -0.5),
        'a0': nrm(L + (RWKV_WIDTH,), 0.1),
        'a2': nrm(L + (AAA_LORA, RWKV_WIDTH), AAA_LORA ** -0.5),
        'g2': nrm(L + (GATE_LORA, RWKV_WIDTH), GATE_LORA ** -0.5),
        'k_k': 0.85 + nrm(L + (RWKV_WIDTH,), 0.05),
        'k_a': 1.0 + nrm(L + (RWKV_WIDTH,), 0.05),
        'r_k': nrm(L + (RWKV_WIDTH,), 0.1),
        'ln_x_w': 1.0 + nrm(L + (RWKV_WIDTH,), 0.05),
        'ln_x_b': nrm(L + (RWKV_WIDTH,), 0.01),
        'w_out': nrm(L + (MIX_WIDTH, D_MODEL), MIX_WIDTH ** -0.5),
        'norm_ffn': 1.0 + nrm(L + (D_MODEL,), 0.05),
        'w_gate': nrm(L + (D_MODEL, D_FF), D_MODEL ** -0.5),
        'w_up': nrm(L + (D_MODEL, D_FF), D_MODEL ** -0.5),
        'w_down': nrm(L + (D_FF, D_MODEL), D_FF ** -0.5),
        'norm_ple': 1.0 + nrm(L + (D_MODEL,), 0.05),
        'w_ple_gate': nrm(L + (D_MODEL, D_MODEL), D_MODEL ** -0.5),
        'w_ple_proj': nrm(L + (PLE_DIM, D_MODEL), PLE_DIM ** -0.5),
        'norm_final': 1.0 + nrm((D_MODEL,), 0.05),
    }


def reference(x_prompt, x_sample, state_ssm, state_conv, state_wkv, state_shift, p_prompt, p_sample,
              norm_mix, w_in, conv_w, conv_b, dt_bias, a_log, d_skip, ssd_norm, shift_mu, w0, w2, a0, a2,
              g2, k_k, k_a, r_k, ln_x_w, ln_x_b, w_out, norm_ffn, w_gate, w_up, w_down, norm_ple,
              w_ple_gate, w_ple_proj, norm_final):
    bp = x_prompt.shape[0]
    dtype = x_prompt.dtype
    hp, hs = x_prompt, x_sample
    ssm_p, conv_p, wkv_p, shift_p = [], [], [], []
    ssm_s, conv_s, wkv_s, shift_s = [], [], [], []
    for i in range(DEPTH):
        w = {
            'norm_mix': norm_mix[i], 'w_in': w_in[i], 'conv_w': conv_w[i], 'conv_b': conv_b[i],
            'dt_bias': dt_bias[i], 'a_log': a_log[i], 'd_skip': d_skip[i], 'ssd_norm': ssd_norm[i],
            'shift_mu': shift_mu[i], 'w0': w0[i], 'w2': w2[i], 'a0': a0[i], 'a2': a2[i], 'g2': g2[i],
            'k_k': k_k[i], 'k_a': k_a[i], 'r_k': r_k[i], 'ln_x_w': ln_x_w[i], 'ln_x_b': ln_x_b[i],
            'w_out': w_out[i], 'norm_ffn': norm_ffn[i], 'w_gate': w_gate[i], 'w_up': w_up[i],
            'w_down': w_down[i], 'norm_ple': norm_ple[i], 'w_ple_gate': w_ple_gate[i],
            'w_ple_proj': w_ple_proj[i],
        }
        hp, s1, c1, k1, t1 = layer(
            hp, p_prompt[i],
            jnp.zeros((bp, SSD_CONV - 1, SSD_CONV_DIM), dtype),
            jnp.zeros((bp, 1, RWKV_PROJ), dtype),
            jnp.zeros((bp, SSD_HEADS, SSD_HEAD_DIM, SSD_STATE), dtype),
            jnp.zeros((bp, RWKV_HEADS, RWKV_HEAD_DIM, RWKV_HEAD_DIM), dtype), w)
        ssm_p.append(s1); conv_p.append(c1); wkv_p.append(k1); shift_p.append(t1)
        hs, s2, c2, k2, t2 = layer(hs, p_sample[i], state_conv[i], state_shift[i], state_ssm[i], state_wkv[i], w)
        ssm_s.append(s2); conv_s.append(c2); wkv_s.append(k2); shift_s.append(t2)
    y_prompt = rmsnorm(hp, norm_final)
    y_sample = rmsnorm(hs, norm_final)
    return (y_prompt, y_sample,
            jnp.stack(ssm_p), jnp.stack(conv_p), jnp.stack(wkv_p), jnp.stack(shift_p),
            jnp.stack(ssm_s), jnp.stack(conv_s), jnp.stack(wkv_s), jnp.stack(shift_s))
```

```cpp
#include <hip/hip_runtime.h>
#include <hip/hip_cooperative_groups.h>
#include <cstdio>
#include <cstdint>
namespace cg = cooperative_groups;
namespace pg8 {
#define PG8_LAS __attribute__((address_space(3)))
typedef unsigned short bf16_t;
typedef short bf16x8 __attribute__((ext_vector_type(8)));
typedef float f32x4 __attribute__((ext_vector_type(4)));
typedef unsigned u32x4 __attribute__((ext_vector_type(4)));
constexpr int BM = 256, BK = 64, HALF = 128, HTB = HALF * BK * 2  , STAGE_BYTES = 8 * HTB, NXCD = 8, WGM = 8;

__host__ __device__ __forceinline__ int lds_byte(int r, int c) { const int st = (r >> 4) * 2 + (c >> 5), rr = r & 15, cc = c & 31, ob = rr * 64 + cc * 2; return st * 1024 + (ob ^ (((ob >> 9) & 1) << 5)); }
__host__ __device__ __forceinline__ void stage_rc(int b, int& R, int& C) { const int st = b / 1024, sb = b % 1024, swz = sb ^ (((sb >> 9) & 1) << 5); R = (st >> 1) * 16 + swz / 64; C = (st & 1) * 32 + (swz % 64) / 2; }
__host__ __device__ __forceinline__ int perm32(int rho) { const int n = rho >> 4, i = rho & 15; return 8 * (i >> 2) + 4 * n + (i & 3); }

struct Unit { int pm, pn; };
struct Gemm { const bf16_t* A; const bf16_t* Bt; int M, N, K; };

struct StaticOrder {
    int nM, nN, nwg, G, c;
    __host__ __device__ void init(int M, int N, int G_, int c_) { nM = M / BM; nN = N / BM; nwg = nM * nN; G = G_; c = c_; }
    __host__ __device__ bool next(int i, Unit& u) const {
        const long L = (long)i * G + c; if (L >= nwg) return false;
        int wgid = (int)L; { const int q = nwg / NXCD, r = nwg % NXCD, xcd = wgid % NXCD, off = wgid / NXCD; wgid = (xcd < r ? xcd * (q + 1) : r * (q + 1) + (xcd - r) * q) + off; }
        const int nig = WGM * nN, gid = wgid / nig, fm = gid * WGM, gsz = (nM - fm) < WGM ? (nM - fm) : WGM;
        u.pm = fm + ((wgid % nig) % gsz); u.pn = (wgid % nig) / gsz; return true;
    }
    __device__ __forceinline__ void a_ready(const Unit&) const {}
    __device__ __forceinline__ void done(const Unit&) const {}
};


template <class Epi, class Sched, bool ALIGN_EPI = false, bool SP2 = false>
__device__ __forceinline__ void gemm_phase(PG8_LAS unsigned char* lds, const Gemm g, const Sched& S, const Epi& E) {
    int tid_ = threadIdx.x; asm volatile("" : "+v"(tid_));
    const int tid = tid_, wid = __builtin_amdgcn_readfirstlane(tid >> 6), lane = tid & 63, wr = wid >> 2, wc = wid & 3, fr = lane & 15, fq = lane >> 4;
    const int K = g.K, nt = K / BK;
    unsigned voffA[2], voffB[2];
#pragma unroll
    for (int i = 0; i < 2; ++i) { int R, C; stage_rc(tid * 16 + i * 8192, R, C); const int Rb = Epi::PERM ? ((R & ~31) + perm32(R & 31)) : R;
        voffA[i] = (unsigned)(R * K + C) * 2u; voffB[i] = (unsigned)(Rb * K + C) * 2u; }
    const size_t kstep = (size_t)(BK * 2);
    const size_t hstep = (size_t)HALF * K * 2;
    const size_t tstep = 2 * hstep;
    const unsigned ldsw = (unsigned)wid * 1024u;
    const int aoff = lds_byte(wr * 64 + fr, fq * 8), boff = lds_byte(wc * 32 + fr, fq * 8);
#define PG8_SA(b, h) (((b) * 2 + (h)) * HTB)
#define PG8_SB(b, h) ((4 + (b) * 2 + (h)) * HTB)
#define PG8_STAGE(bufoff, gbase, voff) do { _Pragma("unroll") for (int _i = 0; _i < 2; ++_i) \
        __builtin_amdgcn_global_load_lds((const unsigned*)((const char*)(gbase) + (voff)[_i]), (PG8_LAS unsigned*)(lds + (bufoff) + ldsw + _i * 8192), 16, 0, 0); } while (0)
#define PG8_LDA(dst, b, h) do { _Pragma("unroll") for (int m = 0; m < 4; ++m) _Pragma("unroll") for (int k = 0; k < 2; ++k) dst[m][k] = *(const PG8_LAS bf16x8*)(lds + PG8_SA(b, h) + aoff + m * 2048 + k * 1024); } while (0)
#define PG8_LDB(dst, b, h) do { _Pragma("unroll") for (int n = 0; n < 2; ++n) _Pragma("unroll") for (int k = 0; k < 2; ++k) dst[n][k] = *(const PG8_LAS bf16x8*)(lds + PG8_SB(b, h) + boff + n * 2048 + k * 1024); } while (0)
#define PG8_MMA(ai, bj, At, Bt) do { __builtin_amdgcn_s_setprio(1); _Pragma("unroll") for (int m = 0; m < 4; ++m) _Pragma("unroll") for (int n = 0; n < 2; ++n) _Pragma("unroll") for (int k = 0; k < 2; ++k) \
        acc[ai][bj][m][n] = __builtin_amdgcn_mfma_f32_16x16x32_bf16(Bt[n][k], At[m][k], acc[ai][bj][m][n], 0, 0, 0); __builtin_amdgcn_s_setprio(0); } while (0)
#define PG8_WAIT_V(n) asm volatile("s_waitcnt vmcnt(" #n ")" ::: "memory")
#define PG8_WAIT_L(n) asm volatile("s_waitcnt lgkmcnt(" #n ")" ::: "memory")
#define PG8_BAR __builtin_amdgcn_s_barrier()
#define PG8_SCHED __builtin_amdgcn_sched_barrier(0)
    Unit cur, nxt; int ui = 0;
    if (!S.next(0, cur)) return;
    f32x4 acc[2][2][4][2];
#pragma unroll
    for (int a = 0; a < 2; ++a)
#pragma unroll
        for (int b = 0; b < 2; ++b)
#pragma unroll
            for (int m = 0; m < 4; ++m)
#pragma unroll
                for (int n = 0; n < 2; ++n) acc[a][b][m][n] = (f32x4){0.f, 0.f, 0.f, 0.f};
    bf16x8 At[4][2], B0[2][2], B1[2][2];
    const char* cA = (const char*)g.A + (size_t)cur.pm * tstep; const char* cB = (const char*)g.Bt + (size_t)cur.pn * tstep;
    S.a_ready(cur);
    if constexpr (SP2) {
        PG8_STAGE(PG8_SB(0, 0), cB, voffB); PG8_STAGE(PG8_SB(0, 1), cB + hstep, voffB); PG8_STAGE(PG8_SA(0, 0), cA, voffA); PG8_STAGE(PG8_SA(0, 1), cA + hstep, voffA);
        if (wr == 1) PG8_BAR;
        PG8_WAIT_V(2); PG8_BAR;
        PG8_STAGE(PG8_SB(1, 0), cB + kstep, voffB); PG8_STAGE(PG8_SA(1, 0), cA + kstep, voffA); PG8_STAGE(PG8_SB(1, 1), cB + hstep + kstep, voffB);
        PG8_WAIT_V(6); PG8_BAR;
    } else {
        PG8_STAGE(PG8_SB(0, 0), cB, voffB); PG8_STAGE(PG8_SA(0, 0), cA, voffA); PG8_STAGE(PG8_SB(0, 1), cB + hstep, voffB); PG8_STAGE(PG8_SA(0, 1), cA + hstep, voffA);
        if (wr == 1) PG8_BAR;
        PG8_WAIT_V(4); PG8_BAR;
        PG8_STAGE(PG8_SB(1, 0), cB + kstep, voffB); PG8_STAGE(PG8_SA(1, 0), cA + kstep, voffA); PG8_STAGE(PG8_SB(1, 1), cB + hstep + kstep, voffB);
        PG8_WAIT_V(6); PG8_BAR;
    }
    for (;;) {
        const bool has_next = S.next(ui + 1, nxt);
        const char* nA = has_next ? (const char*)g.A + (size_t)nxt.pm * tstep : cA; const char* nB = has_next ? (const char*)g.Bt + (size_t)nxt.pn * tstep : cB;
        for (int t = 0; t < nt; t += 2) {
            const bool last = (t == nt - 2);
            const char* a1 = cA + (size_t)(t + 1) * kstep;
            const char* a2 = last ? nA : cA + (size_t)(t + 2) * kstep; const char* b2 = last ? nB : cB + (size_t)(t + 2) * kstep;
            const char* a3 = a2 + kstep; const char* b3 = b2 + kstep;
            if (last && has_next) S.a_ready(nxt);
            if constexpr (SP2) {
            PG8_LDB(B0, 0, 0); PG8_LDB(B1, 0, 1); PG8_SCHED; PG8_LDA(At, 0, 0); PG8_STAGE(PG8_SA(1, 1), a1 + hstep, voffA);
            PG8_WAIT_V(8); PG8_WAIT_L(0); PG8_BAR; PG8_MMA(0, 0, At, B0); PG8_MMA(0, 1, At, B1); PG8_BAR; PG8_SCHED;
            PG8_LDA(At, 0, 1); PG8_STAGE(PG8_SB(0, 0), b2, voffB); PG8_STAGE(PG8_SB(0, 1), b2 + hstep, voffB); PG8_STAGE(PG8_SA(0, 0), a2, voffA);
            PG8_WAIT_V(8); PG8_WAIT_L(0); PG8_BAR; PG8_MMA(1, 0, At, B0); PG8_MMA(1, 1, At, B1); PG8_BAR; PG8_SCHED;
            PG8_LDB(B0, 1, 0); PG8_LDB(B1, 1, 1); PG8_SCHED; PG8_LDA(At, 1, 0); PG8_STAGE(PG8_SA(0, 1), a2 + hstep, voffA);
            PG8_WAIT_V(8); PG8_WAIT_L(0); PG8_BAR; PG8_MMA(0, 0, At, B0); PG8_MMA(0, 1, At, B1); PG8_BAR; PG8_SCHED;
            PG8_LDA(At, 1, 1); PG8_STAGE(PG8_SB(1, 0), b3, voffB); PG8_STAGE(PG8_SB(1, 1), b3 + hstep, voffB); PG8_STAGE(PG8_SA(1, 0), a3, voffA);
            PG8_WAIT_V(8); PG8_WAIT_L(0); PG8_BAR; PG8_MMA(1, 0, At, B0); PG8_MMA(1, 1, At, B1); PG8_BAR; PG8_SCHED;
            if constexpr (Epi::KSCALE) { const int kd = (t + 2) * BK; if (kd == 512 || kd == 1024) E.kscale(acc, cur, kd, wr, fr); }
            } else {
            PG8_LDB(B0, 0, 0); PG8_SCHED; PG8_LDA(At, 0, 0); PG8_STAGE(PG8_SA(1, 1), a1 + hstep, voffA);
            PG8_WAIT_L(8); PG8_BAR; PG8_WAIT_L(0); PG8_MMA(0, 0, At, B0); PG8_BAR; PG8_SCHED;
            PG8_LDB(B1, 0, 1); PG8_STAGE(PG8_SB(0, 0), b2, voffB);
            PG8_BAR; PG8_WAIT_L(0); PG8_MMA(0, 1, At, B1); PG8_BAR;
            PG8_LDA(At, 0, 1); PG8_STAGE(PG8_SA(0, 0), a2, voffA);
            PG8_BAR; PG8_WAIT_L(0); PG8_MMA(1, 0, At, B0); PG8_BAR; PG8_SCHED;
            PG8_STAGE(PG8_SB(0, 1), b2 + hstep, voffB);
            PG8_WAIT_V(6); PG8_BAR; PG8_MMA(1, 1, At, B1); PG8_BAR;
            PG8_LDB(B0, 1, 0); PG8_SCHED; PG8_LDA(At, 1, 0); PG8_STAGE(PG8_SA(0, 1), a2 + hstep, voffA);
            PG8_WAIT_L(8); PG8_BAR; PG8_WAIT_L(0); PG8_MMA(0, 0, At, B0); PG8_BAR; PG8_SCHED;
            PG8_LDB(B1, 1, 1); PG8_STAGE(PG8_SB(1, 0), b3, voffB);
            PG8_BAR; PG8_WAIT_L(0); PG8_MMA(0, 1, At, B1); PG8_BAR;
            PG8_LDA(At, 1, 1); PG8_STAGE(PG8_SA(1, 0), a3, voffA);
            PG8_BAR; PG8_WAIT_L(0); PG8_MMA(1, 0, At, B0); PG8_BAR; PG8_SCHED;
            PG8_STAGE(PG8_SB(1, 1), b3 + hstep, voffB);
            PG8_WAIT_V(6); PG8_BAR; PG8_MMA(1, 1, At, B1); PG8_BAR;
            }
        }
        if constexpr (ALIGN_EPI) { if (wr == 0) PG8_BAR; }
        if constexpr (!Epi::AFTER_DRAIN) { E(acc, cur, wr, wc, fr, fq); S.done(cur); }
        if (!has_next) break;
#pragma unroll
        for (int a = 0; a < 2; ++a)
#pragma unroll
            for (int b = 0; b < 2; ++b)
#pragma unroll
                for (int m = 0; m < 4; ++m)
#pragma unroll
                    for (int n = 0; n < 2; ++n) acc[a][b][m][n] = (f32x4){0.f, 0.f, 0.f, 0.f};
        cur = nxt; cA = nA; cB = nB; ++ui;
        if constexpr (ALIGN_EPI) { if (wr == 1) PG8_BAR; }
    }
    PG8_WAIT_V(0);
    if constexpr (!ALIGN_EPI) { if (wr == 0) PG8_BAR; }
    PG8_BAR;
    if constexpr (Epi::AFTER_DRAIN) { E.fused(acc, cur, wr, wc, fr, fq, lds, wid, lane); S.done(cur); }
#undef PG8_SA
#undef PG8_SB
#undef PG8_STAGE
#undef PG8_LDA
#undef PG8_LDB
#undef PG8_MMA
#undef PG8_WAIT_V
#undef PG8_WAIT_L
#undef PG8_BAR
#undef PG8_SCHED
}
}
namespace pg8 {
__device__ __forceinline__ unsigned cvt_pk_bf16(float lo, float hi) { unsigned r; asm volatile("v_cvt_pk_bf16_f32 %0, %1, %2" : "=v"(r) : "v"(lo), "v"(hi)); return r; }
__device__ __forceinline__ u32x4 pack8(f32x4 v0, f32x4 v1) { u32x4 w; w.x = cvt_pk_bf16(v0[0], v0[1]); w.y = cvt_pk_bf16(v0[2], v0[3]); w.z = cvt_pk_bf16(v1[0], v1[1]); w.w = cvt_pk_bf16(v1[2], v1[3]); return w; }
__device__ __forceinline__ float sq4(f32x4 v) { return (v[0] * v[0] + v[1] * v[1]) + (v[2] * v[2] + v[3] * v[3]); }
constexpr int T_PROMPT = 16384;
struct EpiPlain {
    static constexpr bool PERM = true, AFTER_DRAIN = false, KSCALE = false;
    bf16_t* O; int ldc; int nfull; float* dt;
    __device__ __forceinline__ void operator()(const f32x4 (&acc)[2][2][4][2], const Unit& u, int wr, int wc, int fr, int fq) const {
        const int row0 = u.pm * BM + wr * 64 + fr;
        if (u.pn < nfull) {
            const int col0 = u.pn * BM + wc * 32 + 8 * fq;
#pragma unroll
            for (int ai = 0; ai < 2; ++ai)
#pragma unroll
                for (int m = 0; m < 4; ++m) { bf16_t* rowp = O + (size_t)(row0 + ai * HALF + m * 16) * ldc + col0;
#pragma unroll
                    for (int bj = 0; bj < 2; ++bj) *(u32x4*)(rowp + bj * HALF) = pack8(acc[ai][bj][m][0], acc[ai][bj][m][1]); }
        } else if (dt != nullptr && wc == 0 && fq < 2) {
#pragma unroll
            for (int ai = 0; ai < 2; ++ai)
#pragma unroll
                for (int m = 0; m < 4; ++m) { float* d = dt + (size_t)(row0 + ai * HALF + m * 16) * 16 + 8 * fq; *(f32x4*)d = acc[ai][0][m][0]; *(f32x4*)(d + 4) = acc[ai][0][m][1]; }
        }
    }
};
template <bool KS> struct EpiRes {
    static constexpr bool PERM = true, AFTER_DRAIN = false, KSCALE = KS;
    const unsigned long long* ssqg;
    __device__ __forceinline__ void kscale(f32x4 (&acc)[2][2][4][2], const Unit& u, int kd, int wr, int fr) const {
        const int row0 = u.pm * BM + wr * 64 + fr;
#pragma unroll
        for (int ai = 0; ai < 2; ++ai)
#pragma unroll
            for (int m = 0; m < 4; ++m) { const int row = row0 + ai * HALF + m * 16;
                const float r0 = rsqrtf((float)ssqg[2 * row] * (1.0f / (512.0f * 1048576.0f)) + 1e-6f), r1 = rsqrtf((float)ssqg[2 * row + 1] * (1.0f / (512.0f * 1048576.0f)) + 1e-6f);
                const float sc = (kd == 512) ? r0 / r1 : r1;
#pragma unroll
                for (int bj = 0; bj < 2; ++bj)
#pragma unroll
                    for (int n = 0; n < 2; ++n) acc[ai][bj][m][n] = acc[ai][bj][m][n] * sc; }
    }
    const float* base_p; const float* base_s; float* out; bf16_t* outb; unsigned long long* ssq;
    __device__ __forceinline__ void operator()(const f32x4 (&acc)[2][2][4][2], const Unit& u, int wr, int wc, int fr, int fq) const {
        const int row0 = u.pm * BM + wr * 64 + fr, col0 = u.pn * BM + wc * 32 + 8 * fq;
#pragma unroll
        for (int ai = 0; ai < 2; ++ai)
#pragma unroll
            for (int m = 0; m < 4; ++m) { const int row = row0 + ai * HALF + m * 16;
                const float* bp = (row < T_PROMPT) ? base_p + (size_t)row * 1024 : base_s + (size_t)(row - T_PROMPT) * 1024;
                float* op = out + (size_t)row * 1024; bf16_t* ob = outb + (size_t)row * 1024; float s = 0.f;
#pragma unroll
                for (int bj = 0; bj < 2; ++bj) { const int c = col0 + bj * HALF;
                    const f32x4 v0 = acc[ai][bj][m][0] + *(const f32x4*)(bp + c), v1 = acc[ai][bj][m][1] + *(const f32x4*)(bp + c + 4);
                    *(f32x4*)(op + c) = v0; *(f32x4*)(op + c + 4) = v1; *(u32x4*)(ob + c) = pack8(v0, v1); s += sq4(v0) + sq4(v1); }
                s += __shfl_xor(s, 16); s += __shfl_xor(s, 32);
                if (fq == 0) atomicAdd(ssq + row, (unsigned long long)(s * 1048576.0f)); }
    }
};
struct EpiGU {
    static constexpr bool PERM = true, AFTER_DRAIN = false, KSCALE = false;
    bf16_t* H; const unsigned long long* ssq;
    __device__ __forceinline__ void operator()(const f32x4 (&acc)[2][2][4][2], const Unit& u, int wr, int wc, int fr, int fq) const {
        const int row0 = u.pm * BM + wr * 64 + fr, col0 = u.pn * HALF + wc * 32 + 8 * fq;
#pragma unroll
        for (int ai = 0; ai < 2; ++ai)
#pragma unroll
            for (int m = 0; m < 4; ++m) { const int row = row0 + ai * HALF + m * 16;
                const float rstd = rsqrtf((float)ssq[row] * (1.0f / (1024.0f * 1048576.0f)) + 1e-6f);
                f32x4 o[2];
#pragma unroll
                for (int n = 0; n < 2; ++n) { const f32x4 g = acc[ai][0][m][n] * rstd, uu = acc[ai][1][m][n] * rstd;
#pragma unroll
                    for (int j = 0; j < 4; ++j) o[n][j] = g[j] * __builtin_amdgcn_rcpf(1.0f + __expf(-g[j])) * uu[j]; }
                *(u32x4*)(H + (size_t)row * 2816 + col0) = pack8(o[0], o[1]); }
    }
};
struct EpiPle {
    static constexpr bool PERM = true, AFTER_DRAIN = false, KSCALE = false;
    float* h; const bf16_t* pp; const unsigned long long* ssq2; unsigned long long* ssq3;
    __device__ __forceinline__ void operator()(const f32x4 (&acc)[2][2][4][2], const Unit& u, int wr, int wc, int fr, int fq) const {
        const int row0 = u.pm * BM + wr * 64 + fr, col0 = u.pn * BM + wc * 32 + 8 * fq;
#pragma unroll
        for (int ai = 0; ai < 2; ++ai)
#pragma unroll
            for (int m = 0; m < 4; ++m) { const int row = row0 + ai * HALF + m * 16;
                const float rstd = rsqrtf((float)ssq2[row] * (1.0f / (1024.0f * 1048576.0f)) + 1e-6f);
                float* hp = h + (size_t)row * 1024; const bf16_t* pr = pp + (size_t)row * 1024; float s = 0.f;
#pragma unroll
                for (int bj = 0; bj < 2; ++bj) { const int c = col0 + bj * HALF;
                    const u32x4 pw = *(const u32x4*)(pr + c);
                    f32x4 p0, p1; p0[0] = __uint_as_float(pw.x << 16); p0[1] = __uint_as_float(pw.x & 0xffff0000u); p0[2] = __uint_as_float(pw.y << 16); p0[3] = __uint_as_float(pw.y & 0xffff0000u);
                    p1[0] = __uint_as_float(pw.z << 16); p1[1] = __uint_as_float(pw.z & 0xffff0000u); p1[2] = __uint_as_float(pw.w << 16); p1[3] = __uint_as_float(pw.w & 0xffff0000u);
                    f32x4 v0 = *(const f32x4*)(hp + c), v1 = *(const f32x4*)(hp + c + 4);
                    const f32x4 a0 = acc[ai][bj][m][0] * rstd, a1 = acc[ai][bj][m][1] * rstd;
#pragma unroll
                    for (int j = 0; j < 4; ++j) { v0[j] += p0[j] * __builtin_amdgcn_rcpf(1.0f + __expf(-a0[j])); v1[j] += p1[j] * __builtin_amdgcn_rcpf(1.0f + __expf(-a1[j])); }
                    *(f32x4*)(hp + c) = v0; *(f32x4*)(hp + c + 4) = v1; s += sq4(v0) + sq4(v1); }
                s += __shfl_xor(s, 16); s += __shfl_xor(s, 32);
                if (fq == 0) atomicAdd(ssq3 + row, (unsigned long long)(s * 1048576.0f)); }
    }
};
}
#define LAS __attribute__((address_space(3)))
typedef pg8::bf16_t bf16_t;
typedef pg8::bf16x8 bf16x8;
typedef pg8::f32x4 f32x4;
typedef pg8::u32x4 u32x4;
typedef unsigned u32x2 __attribute__((ext_vector_type(2)));

constexpr int NT_P = 16384, NT_S = 1024, NT = NT_P + NT_S, DM = 1024;
constexpr int PP = 5888;
constexpr int NW_IN = 6144;
constexpr int DFF = 2816, PLE = 256, RWP = 3328, CONVD = 1536;
constexpr int COL_Z = 0, COL_XBC = 1024, COL_RW = 2560;
constexpr size_t MiB = 1u << 20;
constexpr size_t WS_SSQ1 = 0, WS_SSQ2 = 192 * 1024, WS_SSQ3 = 384 * 1024, WS_SSQG = 576 * 1024, WS_BAR = 896 * 1024, WS_ZERO_BYTES = 1 * MiB;
constexpr size_t WS_WIN = 1 * MiB, WS_WOUT = 13 * MiB, WS_WGU = 17 * MiB, WS_WDOWN = 28 * MiB, WS_WPLG = 34 * MiB, WS_WPLP = 36 * MiB;
constexpr size_t WS_W2T = 37 * MiB, WS_A2T = WS_W2T + 128 * 1024, WS_G2T = WS_W2T + 256 * 1024;
constexpr size_t WS_P = 40 * MiB;
constexpr size_t WS_ALO = 247 * MiB;
constexpr size_t WS_DT = 236 * MiB, WS_PB = 238 * MiB;
constexpr size_t WS_H = 40 * MiB, WS_HB = 108 * MiB, WS_FF = 142 * MiB;
static_assert(WS_P + (size_t)NT * PP * 2 <= WS_DT && WS_PB + (size_t)NT * PLE * 2 <= 256 * MiB && WS_FF + (size_t)NT * DFF * 2 <= WS_DT, "ws map");
constexpr size_t O_YP = 0, O_YS = 16777216, O_SSMP = 17825792, O_CONVP = 18874368, O_WKVP = 18911232, O_SHIFTP = 19435520,
                 O_SSMS = 19462144, O_CONVS = 36239360, O_WKVS = 36829184, O_SHIFTS = 45217792, O_END = 45643776;
constexpr int LDS_BYTES = 135168;

__device__ __forceinline__ float bflo(unsigned u) { return __uint_as_float(u << 16); }
__device__ __forceinline__ float bfhi(unsigned u) { return __uint_as_float(u & 0xffff0000u); }
__device__ __forceinline__ float bf1(bf16_t u) { return __uint_as_float(((unsigned)u) << 16); }
__device__ __forceinline__ unsigned pk2(float lo, float hi) { return pg8::cvt_pk_bf16(lo, hi); }
__device__ __forceinline__ float sigm(float x) { return __builtin_amdgcn_rcpf(1.0f + __expf(-x)); }
__device__ __forceinline__ float silu(float x) { return x * __builtin_amdgcn_rcpf(1.0f + __expf(-x)); }
__device__ __forceinline__ float tanh_fast(float x) { return 1.0f - 2.0f * __builtin_amdgcn_rcpf(__expf(2.0f * x) + 1.0f); }
__device__ __forceinline__ float softplus(float x) { const float e = __expf(-fabsf(x)); const float l = (e < 0.01f) ? e * (1.0f - e * (0.5f - e * 0.33333333f)) : __logf(1.0f + e); return fmaxf(x, 0.f) + l; }
__device__ __forceinline__ float wave_sum(float v) {
#pragma unroll
    for (int o = 1; o < 64; o <<= 1) v += __shfl_xor(v, o);
    return v;
}
template <int CTRL> __device__ __forceinline__ float dppf(float x) { return __int_as_float(__builtin_amdgcn_update_dpp(0, __float_as_int(x), CTRL, 0xf, 0xf, true)); }
__device__ __forceinline__ float half_sum(float v) {
    v += dppf<0xB1>(v); v += dppf<0x4E>(v); v += dppf<0x141>(v); v += dppf<0x140>(v);
    const float s0 = __int_as_float(__builtin_amdgcn_readlane(__float_as_int(v), 0)), s1 = __int_as_float(__builtin_amdgcn_readlane(__float_as_int(v), 16));
    const float s2 = __int_as_float(__builtin_amdgcn_readlane(__float_as_int(v), 32)), s3 = __int_as_float(__builtin_amdgcn_readlane(__float_as_int(v), 48));
    return ((threadIdx.x & 32) == 0) ? (s0 + s1) : (s2 + s3);
}
__device__ __forceinline__ float wave_sum_fast(float v) {
    v += dppf<0xB1>(v); v += dppf<0x4E>(v); v += dppf<0x141>(v); v += dppf<0x140>(v);
    const float s0 = __int_as_float(__builtin_amdgcn_readlane(__float_as_int(v), 0)), s1 = __int_as_float(__builtin_amdgcn_readlane(__float_as_int(v), 16));
    const float s2 = __int_as_float(__builtin_amdgcn_readlane(__float_as_int(v), 32)), s3 = __int_as_float(__builtin_amdgcn_readlane(__float_as_int(v), 48));
    return (s0 + s1) + (s2 + s3);
}
__device__ __forceinline__ float red8(float x) {
    x += dppf<0xB1>(x);
    x += dppf<0x4E>(x);
    x += dppf<0x141>(x);
    return x;
}
__device__ __forceinline__ float red16(float x) {
    x += dppf<0xB1>(x); x += dppf<0x4E>(x); x += dppf<0x141>(x); x += dppf<0x140>(x);
    return x;
}
typedef float f32x2v __attribute__((ext_vector_type(2)));
typedef _Float16 h2v __attribute__((ext_vector_type(2)));
typedef __fp16 fh2v __attribute__((ext_vector_type(2)));
__device__ __forceinline__ h2v toh2(unsigned u) { return __builtin_bit_cast(h2v, u); }
#define LBAR() asm volatile("s_waitcnt lgkmcnt(0)\n\ts_barrier" ::: "memory")
#define LDS_WAIT() asm volatile("s_waitcnt lgkmcnt(0)" ::: "memory")
__device__ __forceinline__ bf16x8 ldfrag(const LAS unsigned char* p) { return *(const LAS bf16x8*)p; }
__device__ __forceinline__ bf16x8 frag_from_f32(const LAS float* p) {
    const f32x4 a = *(const LAS f32x4*)p, b = *(const LAS f32x4*)(p + 4);
    return __builtin_bit_cast(bf16x8, pg8::pack8(a, b));
}
#define MFMA16(X, Y, ACC) __builtin_amdgcn_mfma_f32_16x16x32_bf16((X), (Y), (ACC), 0, 0, 0)

struct Args {
    const float* in[36]; float* out; unsigned char* ws;
};
typedef const __attribute__((address_space(4))) Args* CArgs;
__device__ __forceinline__ CArgs get_args() { CArgs p = (CArgs)__builtin_amdgcn_kernarg_segment_ptr(); asm volatile("" : "+s"(p)); return p; }
__device__ __forceinline__ int get_tid() { int t = threadIdx.x; asm volatile("" : "+v"(t)); return t; }

__device__ __forceinline__ int map_row(int code, int n) {
    if (code == 1) return n < 2560 ? n : (n < 2576 ? 5888 + (n - 2560) : n - 16);
    if (code == 2) return (n >> 7) * 256 + (n & 127);
    if (code == 3) return (n >> 7) * 256 + 128 + (n & 127);
    return n;
}
__device__ __forceinline__ void transpose_item(const float* __restrict__ W, int K, int N, bf16_t* WT, const float* __restrict__ gain, int gain_n, int code, LAS float* scr, int item, int lane) {
    const int nblk = (N + 31) / 32, kb = item / nblk, nb = item % nblk, k0 = 64 * kb, n0 = 32 * nb;
#pragma unroll 8
    for (int i = 0; i < 32; ++i) { const int kk = 2 * i + (lane >> 5), n = n0 + (lane & 31);
        float v = (n < N) ? W[(size_t)(k0 + kk) * N + n] : 0.f;
        if (gain != nullptr && (k0 + kk) < gain_n) v *= gain[k0 + kk];
        scr[kk * 33 + (lane & 31)] = v; }
    LDS_WAIT(); asm volatile("" ::: "memory");
    const int c = lane & 7;
#pragma unroll
    for (int j = 0; j < 4; ++j) { const int nl = (lane >> 3) + 8 * j, n = n0 + nl; const LAS float* s = scr + (8 * c) * 33 + nl;
        u32x4 o; o.x = pk2(s[0 * 33], s[1 * 33]); o.y = pk2(s[2 * 33], s[3 * 33]); o.z = pk2(s[4 * 33], s[5 * 33]); o.w = pk2(s[6 * 33], s[7 * 33]);
        if (n < N) *(u32x4*)(WT + (size_t)map_row(code, n) * K + k0 + 8 * c) = o; }
    LDS_WAIT(); asm volatile("" ::: "memory");
}
__device__ __forceinline__ void phase0b(LAS unsigned char* lds, int first_blk) {
    const CArgs ap = get_args();
    const int tid = get_tid(), lane = tid & 63, wave = tid >> 6;
    if ((int)blockIdx.x < first_blk) return;
    LAS float* scr = (LAS float*)(lds + wave * 16384);
    const int gw = ((int)blockIdx.x - first_blk) * 8 + wave, NGW = ((int)gridDim.x - first_blk) * 8;
    unsigned char* ws = ap->ws;
    int base = 0;
#define DO_MAT(SRC, K_, N_, DST, GAIN, GN, CODE) do { const int nitems = ((K_) / 64) * (((N_) + 31) / 32); int first = gw - (base % NGW); if (first < 0) first += NGW; \
        for (int it = first; it < nitems; it += NGW) transpose_item((SRC), (K_), (N_), (bf16_t*)(ws + (DST)), (GAIN), (GN), (CODE), scr, it, lane); base += nitems; } while (0)
    DO_MAT(ap->in[29], 1024, 2816, WS_WGU, ap->in[28], 1024, 2);
    DO_MAT(ap->in[30], 1024, 2816, WS_WGU, ap->in[28], 1024, 3);
    DO_MAT(ap->in[31], 2816, 1024, WS_WDOWN, nullptr, 0, 0);
    DO_MAT(ap->in[33], 1024, 1024, WS_WPLG, ap->in[32], 1024, 0);
    DO_MAT(ap->in[34], 256, 1024, WS_WPLP, nullptr, 0, 0);
#undef DO_MAT
}
__device__ __forceinline__ void phase0(LAS unsigned char* lds) {
    const CArgs ap = get_args();
    const int tid = get_tid(), lane = tid & 63, wave = tid >> 6;
    LAS float* scr = (LAS float*)(lds + wave * 16384);
    const int gw = blockIdx.x * 8 + wave, NGW = gridDim.x * 8;
    unsigned char* ws = ap->ws;
    int base = 0;
#define DO_MAT(SRC, K_, N_, DST, GAIN, GN, CODE) do { const int nitems = ((K_) / 64) * (((N_) + 31) / 32); int first = gw - (base % NGW); if (first < 0) first += NGW; \
        for (int it = first; it < nitems; it += NGW) transpose_item((SRC), (K_), (N_), (bf16_t*)(ws + (DST)), (GAIN), (GN), (CODE), scr, it, lane); base += nitems; } while (0)
    DO_MAT(ap->in[9], 1024, 5904, WS_WIN, nullptr, 0, 1);
    DO_MAT(ap->in[27], 2048, 1024, WS_WOUT, ap->in[15], 1024, 0);
    DO_MAT(ap->in[18], 64, 1024, WS_W2T, nullptr, 0, 0);
    DO_MAT(ap->in[20], 64, 1024, WS_A2T, nullptr, 0, 0);
    DO_MAT(ap->in[21], 128, 1024, WS_G2T, nullptr, 0, 0);
#undef DO_MAT
    bf16_t* xn = (bf16_t*)(ap->out + O_SSMS);
    const float* gmix = ap->in[8];
    f32x4 gv[4];
#pragma unroll
    for (int j = 0; j < 4; ++j) gv[j] = *(const f32x4*)(gmix + 4 * lane + 256 * j);
    for (int m = gw; m < NT; m += 2 * NGW) {
        const int m2 = m + NGW; const bool has2 = m2 < NT;
        const float* xr = (m < NT_P) ? ap->in[0] + (size_t)m * DM : ap->in[1] + (size_t)(m - NT_P) * DM;
        const float* xr2 = has2 ? ((m2 < NT_P) ? ap->in[0] + (size_t)m2 * DM : ap->in[1] + (size_t)(m2 - NT_P) * DM) : xr;
        f32x4 v[4], u[4]; float s = 0.f, s2 = 0.f;
#pragma unroll
        for (int j = 0; j < 4; ++j) { v[j] = *(const f32x4*)(xr + 4 * lane + 256 * j); u[j] = *(const f32x4*)(xr2 + 4 * lane + 256 * j); }
#pragma unroll
        for (int j = 0; j < 4; ++j) { s += pg8::sq4(v[j]); s2 += pg8::sq4(u[j]); }
        const float rstd = rsqrtf(wave_sum_fast(s) * (1.0f / DM) + 1e-6f), rstd2 = rsqrtf(wave_sum_fast(s2) * (1.0f / DM) + 1e-6f);
#pragma unroll
        for (int j = 0; j < 4; ++j) { const f32x4 o = v[j] * rstd * gv[j]; u32x2 w; w.x = pk2(o[0], o[1]); w.y = pk2(o[2], o[3]); *(u32x2*)(xn + (size_t)m * DM + 4 * lane + 256 * j) = w; }
        if (has2) {
#pragma unroll
            for (int j = 0; j < 4; ++j) { const f32x4 o = u[j] * rstd2 * gv[j]; u32x2 w; w.x = pk2(o[0], o[1]); w.y = pk2(o[2], o[3]); *(u32x2*)(xn + (size_t)m2 * DM + 4 * lane + 256 * j) = w; } }
    }
    bf16_t* pb = (bf16_t*)(ws + WS_PB);
    for (int m = gw; m < NT; m += NGW) {
        const float* pr = (m < NT_P) ? ap->in[6] + (size_t)m * PLE : ap->in[7] + (size_t)(m - NT_P) * PLE;
        const f32x4 v = *(const f32x4*)(pr + 4 * lane); u32x2 w; w.x = pk2(v[0], v[1]); w.y = pk2(v[2], v[3]);
        *(u32x2*)(pb + (size_t)m * PLE + 4 * lane) = w;
    }
}
constexpr int US = 452;
__device__ __forceinline__ int rw_pcol(int cgp, int h) {
    return cgp < 8 ? COL_RW + h * 64 + 8 * cgp : cgp < 16 ? COL_RW + 1024 + h * 64 + 8 * (cgp - 8) : cgp < 24 ? COL_RW + 2048 + h * 64 + 8 * (cgp - 16) : COL_RW + 3072 + 8 * (cgp - 24);
}
__device__ __forceinline__ bool rw_item(int q, int tid, int& tok, int& cgp) {
    if (q == 0 && tid < 384) { tok = tid / 24; cgp = tid - tok * 24; return true; }
    return false;
}
__device__ __forceinline__ void phase_alo() {
    const CArgs ap = get_args();
    const int tid = get_tid();
    const bf16_t* __restrict__ P = (const bf16_t*)(ap->ws + WS_P);
    bf16_t* ALO = (bf16_t*)(ap->ws + WS_ALO);
    const float* __restrict__ mu = ap->in[16] + 3072; const float* __restrict__ sh = ap->in[5];
    for (int idx = blockIdx.x * 512 + tid; idx < NT * 32; idx += gridDim.x * 512) {
        const int row = idx >> 5, g = idx & 31, col = 8 * g;
        const u32x4 cw = *(const u32x4*)(P + (size_t)row * PP + COL_RW + 3072 + col);
        const int t = row < NT_P ? (row & 2047) : ((row - NT_P) & 7);
        float cur[8] = {bflo(cw.x), bfhi(cw.x), bflo(cw.y), bfhi(cw.y), bflo(cw.z), bfhi(cw.z), bflo(cw.w), bfhi(cw.w)}, prv[8];
        if (t > 0) { const u32x4 pw = *(const u32x4*)(P + (size_t)(row - 1) * PP + COL_RW + 3072 + col);
            prv[0] = bflo(pw.x); prv[1] = bfhi(pw.x); prv[2] = bflo(pw.y); prv[3] = bfhi(pw.y); prv[4] = bflo(pw.z); prv[5] = bfhi(pw.z); prv[6] = bflo(pw.w); prv[7] = bfhi(pw.w); }
        else if (row >= NT_P) { const float* sp = sh + (size_t)((row - NT_P) >> 3) * RWP + 3072 + col; const f32x4 s0a = *(const f32x4*)sp, s0b = *(const f32x4*)(sp + 4);
#pragma unroll
            for (int i = 0; i < 4; ++i) { prv[i] = s0a[i]; prv[4 + i] = s0b[i]; } }
        else {
#pragma unroll
            for (int i = 0; i < 8; ++i) prv[i] = 0.f; }
        const f32x4 m0 = *(const f32x4*)(mu + col), m1 = *(const f32x4*)(mu + col + 4);
        float o[8];
#pragma unroll
        for (int i = 0; i < 8; ++i) { const float m = i < 4 ? m0[i] : m1[i - 4]; float v = cur[i] + (prv[i] - cur[i]) * m;
            if (g < 8) v = tanh_fast(v); else if (g >= 16) v = sigm(v);
            o[i] = v; }
        u32x4 w; w.x = pk2(o[0], o[1]); w.y = pk2(o[2], o[3]); w.z = pk2(o[4], o[5]); w.w = pk2(o[6], o[7]);
        *(u32x4*)(ALO + (size_t)row * 256 + col) = w;
    }
}
template <bool PROMPT> __device__ __forceinline__ void rwkv_task(LAS unsigned char* lds, CArgs ap, int h, int row0, int L, const float* __restrict__ s0, const float* __restrict__ shift0, float* __restrict__ sout) {
    const bf16_t* __restrict__ P = (const bf16_t*)(ap->ws + WS_P);
    bf16_t* Y = (bf16_t*)ap->out;
    const float* __restrict__ mu = ap->in[16];
    LAS float* U = (LAS float*)lds;
    LAS float* Wd = U + 16 * US; LAS float* Aa = Wd + 1024; LAS float* Gg = Aa + 1024; LAS float* KK = Gg + 1024; LAS float* KKA = KK + 1024; LAS float* KP = KKA + 1024; LAS float* Oo = KP + 1024; LAS float* SB = Oo + 1024; LAS float* OoP = SB + 64;
    LAS _Float16* Wd16 = (LAS _Float16*)Wd; LAS _Float16* KK16 = (LAS _Float16*)KK; LAS _Float16* KKA16 = (LAS _Float16*)KKA; LAS _Float16* KP16 = (LAS _Float16*)KP; LAS _Float16* R16 = (LAS _Float16*)Oo;
    const int tid = get_tid(), lane = tid & 63, wave = tid >> 6;
    const int tokl = lane & 15, kq = 8 * (lane >> 4), ct = wave & 3;
    bf16x8 wf[4];
    {
        const int col = h * 64 + 16 * ct + tokl;
        if (wave < 4) {
            const bf16_t* w2t = (const bf16_t*)(ap->ws + WS_W2T) + (size_t)col * 64 + kq; const bf16_t* a2t = (const bf16_t*)(ap->ws + WS_A2T) + (size_t)col * 64 + kq;
            wf[0] = *(const bf16x8*)w2t; wf[1] = *(const bf16x8*)(w2t + 32); wf[2] = *(const bf16x8*)a2t; wf[3] = *(const bf16x8*)(a2t + 32);
        } else {
            const bf16_t* g2t = (const bf16_t*)(ap->ws + WS_G2T) + (size_t)col * 128 + kq;
#pragma unroll
            for (int s = 0; s < 4; ++s) wf[s] = *(const bf16x8*)(g2t + 32 * s);
        }
    }
    const int ecol = h * 64 + 16 * ct + 4 * (lane >> 4);
    const f32x4 w0v = *(const f32x4*)(ap->in[17] + ecol), a0v = *(const f32x4*)(ap->in[19] + ecol);
    const int etok = tid >> 5, c2 = 2 * (tid & 31), gc = h * 64 + c2;
    const float kkw0 = ap->in[22][gc], kkw1 = ap->in[22][gc + 1], ka0 = ap->in[23][gc], ka1 = ap->in[23][gc + 1], rk0 = ap->in[24][gc], rk1 = ap->in[24][gc + 1];
    const float lnw0 = ap->in[25][gc], lnw1 = ap->in[25][gc + 1], lnb0 = ap->in[26][gc], lnb1 = ap->in[26][gc + 1];
    const int rl = lane >> 3, kg = lane & 7, srow = wave * 8 + rl;
    h2v S2[4];
    if (s0 != nullptr) { const f32x4 x0 = *(const f32x4*)(s0 + srow * 64 + 8 * kg), x1 = *(const f32x4*)(s0 + srow * 64 + 8 * kg + 4);
        S2[0] = (h2v){(_Float16)x0[0], (_Float16)x0[1]}; S2[1] = (h2v){(_Float16)x0[2], (_Float16)x0[3]}; S2[2] = (h2v){(_Float16)x1[0], (_Float16)x1[1]}; S2[3] = (h2v){(_Float16)x1[2], (_Float16)x1[3]}; }
    else {
#pragma unroll
        for (int i = 0; i < 4; ++i) S2[i] = (h2v){(_Float16)0.f, (_Float16)0.f}; }
    const int nchunk = (L + 15) / 16;
    u32x4 rc[2], rp[2];
#define RW_LOAD(C) do { _Pragma("unroll") for (int q = 0; q < 2; ++q) { int tok, cgp; rc[q] = (u32x4){0u, 0u, 0u, 0u}; rp[q] = (u32x4){0u, 0u, 0u, 0u}; \
        if (rw_item(q, tid, tok, cgp)) { const int t = 16 * (C) + tok; const int pc = rw_pcol(cgp, h); \
            if (t < L) { rc[q] = *(const u32x4*)(P + (size_t)(row0 + t) * PP + pc); if (t > 0) rp[q] = *(const u32x4*)(P + (size_t)(row0 + t - 1) * PP + pc); } } } } while (0)
    f32x4 muv[2][2];
#pragma unroll
    for (int q = 0; q < 2; ++q) { int tok, cgp; muv[q][0] = (f32x4){0.f, 0.f, 0.f, 0.f}; muv[q][1] = muv[q][0];
        if (rw_item(q, tid, tok, cgp)) { const int mj = rw_pcol(cgp, h) - COL_RW; muv[q][0] = *(const f32x4*)(mu + mj); muv[q][1] = *(const f32x4*)(mu + mj + 4); } }
    const bf16_t* __restrict__ ALO = (const bf16_t*)(ap->ws + WS_ALO);
    bf16x8 af[4];
#define AF_LOAD(C) do { int r_ = row0 + 16 * (C) + tokl; r_ = r_ < NT ? r_ : NT - 1; const bf16_t* ar_ = ALO + (size_t)r_ * 256 + kq; \
        if (wave < 4) { af[0] = *(const bf16x8*)ar_; af[1] = *(const bf16x8*)(ar_ + 32); af[2] = *(const bf16x8*)(ar_ + 64); af[3] = *(const bf16x8*)(ar_ + 96); } \
        else { af[0] = *(const bf16x8*)(ar_ + 128); af[1] = *(const bf16x8*)(ar_ + 160); af[2] = *(const bf16x8*)(ar_ + 192); af[3] = *(const bf16x8*)(ar_ + 224); } } while (0)
    AF_LOAD(0);
    RW_LOAD(0);
    for (int c = 0; c < nchunk; ++c) {
#pragma unroll
        for (int q = 0; q < 2; ++q) { int tok, cgp;
            if (rw_item(q, tid, tok, cgp)) { const int t = 16 * c + tok; const int mj = rw_pcol(cgp, h) - COL_RW;
                float cur[8], prv[8];
                cur[0] = bflo(rc[q].x); cur[1] = bfhi(rc[q].x); cur[2] = bflo(rc[q].y); cur[3] = bfhi(rc[q].y); cur[4] = bflo(rc[q].z); cur[5] = bfhi(rc[q].z); cur[6] = bflo(rc[q].w); cur[7] = bfhi(rc[q].w);
                prv[0] = bflo(rp[q].x); prv[1] = bfhi(rp[q].x); prv[2] = bflo(rp[q].y); prv[3] = bfhi(rp[q].y); prv[4] = bflo(rp[q].z); prv[5] = bfhi(rp[q].z); prv[6] = bflo(rp[q].w); prv[7] = bfhi(rp[q].w);
                if (t == 0 && shift0 != nullptr) { const f32x4 s0a = *(const f32x4*)(shift0 + mj), s0b = *(const f32x4*)(shift0 + mj + 4);
#pragma unroll
                    for (int i = 0; i < 4; ++i) { prv[i] = s0a[i]; prv[4 + i] = s0b[i]; } }
                const f32x4 m0 = muv[q][0], m1 = muv[q][1];
                float o[8];
#pragma unroll
                for (int i = 0; i < 8; ++i) { const float m = i < 4 ? m0[i] : m1[i - 4]; float v = cur[i] + (prv[i] - cur[i]) * m;
                    if (q == 1) { if (tid < 128) v = tanh_fast(v); else v = sigm(v); }
                    o[i] = (PROMPT || t < L) ? v : 0.f; }
                *(LAS f32x4*)(U + tok * US + 8 * cgp) = (f32x4){o[0], o[1], o[2], o[3]}; *(LAS f32x4*)(U + tok * US + 8 * cgp + 4) = (f32x4){o[4], o[5], o[6], o[7]}; } }
        if (c + 1 < nchunk) RW_LOAD(c + 1);
        LBAR();
        if (wave < 4) {
            f32x4 accw = {0.f, 0.f, 0.f, 0.f}, acca = {0.f, 0.f, 0.f, 0.f};
#pragma unroll
            for (int s = 0; s < 2; ++s) { accw = MFMA16(wf[s], af[s], accw); acca = MFMA16(wf[2 + s], af[2 + s], acca); }
            f32x4 dv, av;
#pragma unroll
            for (int j = 0; j < 4; ++j) { const float x = w0v[j] + accw[j]; dv[j] = __expf(-0.60653066f * sigm(x)); av[j] = sigm(a0v[j] + acca[j]); }
            *(LAS h2v*)(Wd16 + tokl * 64 + 16 * ct + 4 * (lane >> 4)) = (h2v){(_Float16)dv[0], (_Float16)dv[1]}; *(LAS h2v*)(Wd16 + tokl * 64 + 16 * ct + 4 * (lane >> 4) + 2) = (h2v){(_Float16)dv[2], (_Float16)dv[3]};
            *(LAS f32x4*)(Aa + tokl * 64 + 16 * ct + 4 * (lane >> 4)) = av;
        } else {
            f32x4 accg = {0.f, 0.f, 0.f, 0.f};
#pragma unroll
            for (int s = 0; s < 4; ++s) accg = MFMA16(wf[s], af[s], accg);
            *(LAS f32x4*)(Gg + tokl * 64 + 16 * ct + 4 * (lane >> 4)) = accg;
        }
        LBAR();
        if (c + 1 < nchunk) AF_LOAD(c + 1);
        {
            const float k0 = U[etok * US + 64 + c2], k1 = U[etok * US + 64 + c2 + 1], av0 = Aa[etok * 64 + c2], av1 = Aa[etok * 64 + c2 + 1];
            const float r0 = U[etok * US + c2], r1 = U[etok * US + c2 + 1];
            float q0 = k0 * kkw0, q1 = k1 * kkw1;
            const float ss = half_sum(q0 * q0 + q1 * q1);
            const float inv = fminf(rsqrtf(ss), 1e12f);
            q0 *= inv; q1 *= inv;
            const float kp0 = k0 * (1.0f + (av0 - 1.0f) * ka0), kp1 = k1 * (1.0f + (av1 - 1.0f) * ka1);
            *(LAS h2v*)(KK16 + etok * 64 + c2) = (h2v){(_Float16)q0, (_Float16)q1}; *(LAS h2v*)(KKA16 + etok * 64 + c2) = (h2v){(_Float16)(q0 * av0), (_Float16)(q1 * av1)};
            *(LAS h2v*)(KP16 + etok * 64 + c2) = (h2v){(_Float16)kp0, (_Float16)kp1}; *(LAS h2v*)(R16 + etok * 64 + c2) = (h2v){(_Float16)r0, (_Float16)r1};
            const float sb = half_sum(r0 * kp0 * rk0 + r1 * kp1 * rk1);
            if ((tid & 31) == 0) SB[etok] = sb;
        }
        LBAR();
        const int nv = PROMPT ? 16 : ((L - 16 * c) < 16 ? (L - 16 * c) : 16);
        u32x4 opA[5], opB[5]; float vA, vB;
#define RW_OPS(DST, VD, TOK) do { DST[0] = *(const LAS u32x4*)(Wd16 + (TOK) * 64 + 8 * kg); DST[1] = *(const LAS u32x4*)(KK16 + (TOK) * 64 + 8 * kg); \
            DST[2] = *(const LAS u32x4*)(KKA16 + (TOK) * 64 + 8 * kg); DST[3] = *(const LAS u32x4*)(KP16 + (TOK) * 64 + 8 * kg); \
            DST[4] = *(const LAS u32x4*)(R16 + (TOK) * 64 + 8 * kg); VD = U[(TOK) * US + 128 + srow]; } while (0)
#define H2(X, I) toh2((X)[I])
#define FD2(A, B, C) __builtin_amdgcn_fdot2(__builtin_bit_cast(fh2v, (A)), __builtin_bit_cast(fh2v, (B)), (C), false)
#define RW_STEP(SRC, VS, TOK) do { \
            float sk_ = FD2(S2[0], H2(SRC[1], 0), 0.f); sk_ = FD2(S2[1], H2(SRC[1], 1), sk_); sk_ = FD2(S2[2], H2(SRC[1], 2), sk_); sk_ = FD2(S2[3], H2(SRC[1], 3), sk_); \
            sk_ = red8(sk_); \
            const h2v nsk_ = __builtin_bit_cast(h2v, __builtin_amdgcn_cvt_pkrtz(-sk_, -sk_)), vv_ = __builtin_bit_cast(h2v, __builtin_amdgcn_cvt_pkrtz(VS, VS)); \
            _Pragma("unroll") for (int i = 0; i < 4; ++i) { h2v t_ = vv_ * H2(SRC[3], i); t_ = nsk_ * H2(SRC[2], i) + t_; S2[i] = S2[i] * H2(SRC[0], i) + t_; } \
            float q_ = FD2(S2[0], H2(SRC[4], 0), 0.f); q_ = FD2(S2[1], H2(SRC[4], 1), q_); q_ = FD2(S2[2], H2(SRC[4], 2), q_); q_ = FD2(S2[3], H2(SRC[4], 3), q_); \
            OoP[((TOK) * 64 + srow) * 8 + kg] = q_; } while (0)
        RW_OPS(opA, vA, 0);
#pragma unroll 1
        for (int tok = 0; tok < nv; tok += 2) {
            RW_OPS(opB, vB, tok + 1);
            RW_STEP(opA, vA, tok);
            RW_OPS(opA, vA, (tok + 2) & 15);
            RW_STEP(opB, vB, tok + 1);
        }
#undef RW_OPS
#undef RW_STEP
#undef H2
#undef FD2
        LBAR();
        {
            float o0, o1;
            { const LAS f32x4* op_ = (const LAS f32x4*)(OoP + (etok * 64 + c2) * 8); const f32x4 a0 = op_[0], a1 = op_[1], b0 = op_[2], b1 = op_[3];
              o0 = ((a0[0] + a0[1]) + (a0[2] + a0[3])) + ((a1[0] + a1[1]) + (a1[2] + a1[3])); o1 = ((b0[0] + b0[1]) + (b0[2] + b0[3])) + ((b1[0] + b1[1]) + (b1[2] + b1[3])); }
            const float mean = half_sum(o0 + o1) * (1.0f / 64.0f);
            const float d0 = o0 - mean, d1 = o1 - mean;
            const float var = half_sum(d0 * d0 + d1 * d1) * (1.0f / 64.0f);
            const float rs = rsqrtf(var + 64e-5f);
            const float sb = SB[etok], v0 = U[etok * US + 128 + c2], v1 = U[etok * US + 128 + c2 + 1];
            const float y0 = (d0 * rs * lnw0 + lnb0 + sb * v0) * Gg[etok * 64 + c2], y1 = (d1 * rs * lnw1 + lnb1 + sb * v1) * Gg[etok * 64 + c2 + 1];
            if (etok < nv) *(unsigned*)(Y + (size_t)(row0 + 16 * c + etok) * 2048 + 1024 + gc) = pk2(y0, y1);
        }
        LBAR();
    }
#undef RW_LOAD
#undef AF_LOAD
    *(f32x4*)(sout + srow * 64 + 8 * kg) = (f32x4){(float)S2[0].x, (float)S2[0].y, (float)S2[1].x, (float)S2[1].y}; *(f32x4*)(sout + srow * 64 + 8 * kg + 4) = (f32x4){(float)S2[2].x, (float)S2[2].y, (float)S2[3].x, (float)S2[3].y};
}
constexpr int S_CS = 0, S_BS = 17408, S_BT = 34816, S_XT = 53248, S_XW = 62464, S_SB = 71680, S_FL = 89088;
__device__ __forceinline__ void ssd_prompt_task(LAS unsigned char* lds, CArgs ap, int b, int h) {
    const bf16_t* __restrict__ P = (const bf16_t*)(ap->ws + WS_P);
    const float* __restrict__ dtraw = (const float*)(ap->ws + WS_DT);
    bf16_t* Y = (bf16_t*)ap->out;
    unsigned long long* ssqg = (unsigned long long*)(ap->ws + WS_SSQG);
    const int tid = get_tid(), lane = tid & 63, wave = tid >> 6, g = h >> 3;
    const int row0 = b * 2048;
    LAS float* acum = (LAS float*)(lds + S_FL); LAS float* dtv = acum + 64; LAS float* wgt = dtv + 64; LAS float* eac = wgt + 64; LAS float* misc = eac + 64;
    const float ah = -__expf(ap->in[13][h]), dtb = ap->in[12][h], Dh = ap->in[14][h];
    const int grp = tid % 80, run = tid / 80;
    int kind, pc, cc, loc;
    if (grp < 16) { kind = 0; loc = 4 * grp; pc = COL_XBC + h * 64 + loc; cc = h * 64 + loc; }
    else if (grp < 48) { kind = 1; loc = 4 * (grp - 16); pc = COL_XBC + 1024 + g * 128 + loc; cc = 1024 + g * 128 + loc; }
    else { kind = 2; loc = 4 * (grp - 48); pc = COL_XBC + 1280 + g * 128 + loc; cc = 1280 + g * 128 + loc; }
    f32x4 cw[4], cb;
    if (tid < 320) {
#pragma unroll
        for (int j = 0; j < 4; ++j) cw[j] = *(const f32x4*)(ap->in[10] + j * CONVD + cc);
        cb = *(const f32x4*)(ap->in[11] + cc);
    }
    const int tl = lane & 15, kq = 8 * (lane >> 4), q4 = 4 * (lane >> 4);
    const int qt = wave & 3, w2 = wave >> 2;
    f32x4 Sacc[4];
#pragma unroll
    for (int i = 0; i < 4; ++i) Sacc[i] = (f32x4){0.f, 0.f, 0.f, 0.f};
    for (int i = tid; i < 17408 / 4; i += 512) ((LAS unsigned*)(lds + S_SB))[i] = 0u;
    u32x2 raw[19];
#define RAWLD(CK) do { const int tb_ = 64 * (CK) + 16 * run - 3; _Pragma("unroll") for (int j = 0; j < 19; ++j) { const int t_ = tb_ + j; raw[j] = (u32x2){0u, 0u}; \
        if (t_ >= 0) raw[j] = *(const u32x2*)(P + (size_t)(row0 + t_) * PP + pc); } } while (0)
#define RAWF(J) ((f32x4){bflo(raw[J].x), bfhi(raw[J].x), bflo(raw[J].y), bfhi(raw[J].y)})
    if (tid < 320) RAWLD(0);
    for (int ck = 0; ck < 32; ++ck) {
        const int t0 = 64 * ck;
        if (tid < 320) {
            f32x4 r0, r1, r2;
            r0 = RAWF(0); r1 = RAWF(1); r2 = RAWF(2);
#pragma unroll
            for (int i = 0; i < 16; i += 2) {
                const f32x4 r3 = RAWF(3 + i), r4 = RAWF(4 + i);
                f32x4 oa = cb + cw[0] * r0 + cw[1] * r1 + cw[2] * r2 + cw[3] * r3;
                f32x4 ob = cb + cw[0] * r1 + cw[1] * r2 + cw[2] * r3 + cw[3] * r4;
#pragma unroll
                for (int j = 0; j < 4; ++j) { oa[j] = silu(oa[j]); ob[j] = silu(ob[j]); }
                const int tok = 16 * run + i;
                if (kind == 0) {
#pragma unroll
                    for (int j = 0; j < 4; ++j) *(LAS unsigned*)(lds + S_XT + (loc + j) * 144 + tok * 2) = pk2(oa[j], ob[j]);
                } else if (kind == 1) {
                    u32x2 wa, wb; wa.x = pk2(oa[0], oa[1]); wa.y = pk2(oa[2], oa[3]); wb.x = pk2(ob[0], ob[1]); wb.y = pk2(ob[2], ob[3]);
                    *(LAS u32x2*)(lds + S_BS + tok * 272 + loc * 2) = wa; *(LAS u32x2*)(lds + S_BS + (tok + 1) * 272 + loc * 2) = wb;
#pragma unroll
                    for (int j = 0; j < 4; ++j) *(LAS unsigned*)(lds + S_BT + (loc + j) * 144 + tok * 2) = pk2(oa[j], ob[j]);
                } else {
                    u32x2 wa, wb; wa.x = pk2(oa[0], oa[1]); wa.y = pk2(oa[2], oa[3]); wb.x = pk2(ob[0], ob[1]); wb.y = pk2(ob[2], ob[3]);
                    *(LAS u32x2*)(lds + S_CS + tok * 272 + loc * 2) = wa; *(LAS u32x2*)(lds + S_CS + (tok + 1) * 272 + loc * 2) = wb;
                }
                r0 = r2; r1 = r3; r2 = r4;
            }
            if (ck + 1 < 32) RAWLD(ck + 1);
        } else if (tid < 384) {
            const int tok = tid - 320;
            const float dt = softplus(dtraw[(size_t)(row0 + t0 + tok) * 16 + h] + dtb);
            float ac = dt * ah;
#pragma unroll
            for (int o = 1; o < 64; o <<= 1) { const float n = __shfl_up(ac, o); if (tok >= o) ac += n; }
            const float last = __shfl(ac, 63);
            acum[tok] = ac; dtv[tok] = dt; wgt[tok] = __expf(last - ac) * dt; eac[tok] = __expf(ac);
            if (tok == 0) misc[0] = __expf(last);
        }
        LBAR();
        { const int p = tid >> 3, s0 = (tid & 7) * 8; const u32x4 xv = *(const LAS u32x4*)(lds + S_XT + p * 144 + s0 * 2);
          const f32x4 wa = *(const LAS f32x4*)(wgt + s0), wb = *(const LAS f32x4*)(wgt + s0 + 4);
          u32x4 o; o.x = pk2(bflo(xv.x) * wa[0], bfhi(xv.x) * wa[1]); o.y = pk2(bflo(xv.y) * wa[2], bfhi(xv.y) * wa[3]); o.z = pk2(bflo(xv.z) * wb[0], bfhi(xv.z) * wb[1]); o.w = pk2(bflo(xv.w) * wb[2], bfhi(xv.w) * wb[3]);
          *(LAS u32x4*)(lds + S_XW + p * 144 + s0 * 2) = o; }
        u32x2 zpre[2];
#pragma unroll
        for (int i = 0; i < 2; ++i) zpre[i] = *(const u32x2*)(P + (size_t)(row0 + t0 + 16 * qt + tl) * PP + COL_Z + h * 64 + 16 * (2 * w2 + i) + q4);
        f32x4 G[2], Yc[2];
#pragma unroll
        for (int i = 0; i < 2; ++i) { G[i] = (f32x4){0.f, 0.f, 0.f, 0.f}; Yc[i] = (f32x4){0.f, 0.f, 0.f, 0.f}; }
#pragma unroll
        for (int ks = 0; ks < 4; ++ks) {
            const bf16x8 cf = ldfrag(lds + S_CS + (16 * qt + tl) * 272 + (32 * ks + kq) * 2);
#pragma unroll
            for (int i = 0; i < 2; ++i) {
                const int t2 = 2 * w2 + i;
                if (t2 <= qt) G[i] = MFMA16(ldfrag(lds + S_BS + (16 * t2 + tl) * 272 + (32 * ks + kq) * 2), cf, G[i]);
                Yc[i] = MFMA16(ldfrag(lds + S_SB + (16 * t2 + tl) * 272 + (32 * ks + kq) * 2), cf, Yc[i]);
            }
        }
        LBAR();
        {
            const int q = 16 * qt + tl; const float aq = acum[q], eq = eac[q];
#pragma unroll
            for (int i = 0; i < 2; ++i) { const int sb = 16 * (2 * w2 + i) + q4; float wv[4];
#pragma unroll
                for (int j = 0; j < 4; ++j) { const int s = sb + j; wv[j] = (s <= q) ? G[i][j] * __expf(aq - acum[s]) * dtv[s] : 0.f; }
                u32x2 o; o.x = pk2(wv[0], wv[1]); o.y = pk2(wv[2], wv[3]);
                *(LAS u32x2*)(lds + S_BS + q * 144 + sb * 2) = o;
                Yc[i] = Yc[i] * eq; }
        }
        LBAR();
        const float dec = misc[0];
#pragma unroll
        for (int i = 0; i < 4; ++i) Sacc[i] = Sacc[i] * dec;
#pragma unroll
        for (int ks = 0; ks < 2; ++ks) {
            const bf16x8 wfr = ldfrag(lds + S_BS + (16 * qt + tl) * 144 + (32 * ks + kq) * 2);
            const bf16x8 xwf = ldfrag(lds + S_XW + (16 * qt + tl) * 144 + (32 * ks + kq) * 2);
#pragma unroll
            for (int i = 0; i < 2; ++i) Yc[i] = MFMA16(ldfrag(lds + S_XT + (16 * (2 * w2 + i) + tl) * 144 + (32 * ks + kq) * 2), wfr, Yc[i]);
#pragma unroll
            for (int i = 0; i < 4; ++i) Sacc[i] = MFMA16(ldfrag(lds + S_BT + (16 * (4 * w2 + i) + tl) * 144 + (32 * ks + kq) * 2), xwf, Sacc[i]);
        }
        {
            const int q = 16 * qt + tl; const size_t grow = (size_t)(row0 + t0 + q);
            float ssl = 0.f;
#pragma unroll
            for (int i = 0; i < 2; ++i) { const int p0 = 16 * (2 * w2 + i) + q4;
                const u32x2 zw = zpre[i];
                const float z[4] = {bflo(zw.x), bfhi(zw.x), bflo(zw.y), bfhi(zw.y)}; float yv[4];
#pragma unroll
                for (int j = 0; j < 4; ++j) { const float xv = bf1(*(const LAS bf16_t*)(lds + S_XT + (p0 + j) * 144 + q * 2)); yv[j] = (Yc[i][j] + Dh * xv) * silu(z[j]); }
                u32x2 o; o.x = pk2(yv[0], yv[1]); o.y = pk2(yv[2], yv[3]);
                *(u32x2*)(Y + grow * 2048 + h * 64 + p0) = o;
                ssl += bflo(o.x) * bflo(o.x) + bfhi(o.x) * bfhi(o.x) + bflo(o.y) * bflo(o.y) + bfhi(o.y) * bfhi(o.y); }
            ssl += __shfl_xor(ssl, 16); ssl += __shfl_xor(ssl, 32);
            if (lane < 16) atomicAdd(ssqg + 2 * grow + g, (unsigned long long)(ssl * 1048576.0f));
        }
#pragma unroll
        for (int i = 0; i < 4; ++i) { u32x2 o; o.x = pk2(Sacc[i][0], Sacc[i][1]); o.y = pk2(Sacc[i][2], Sacc[i][3]);
            *(LAS u32x2*)(lds + S_SB + (16 * qt + tl) * 272 + (16 * (4 * w2 + i) + q4) * 2) = o; }
        LBAR();
    }
#undef RAWLD
#undef RAWF
    float* so = ap->out + O_SSMP + ((size_t)(b * 16 + h) * 64) * 128;
#pragma unroll
    for (int i = 0; i < 4; ++i) *(f32x4*)(so + (size_t)(16 * qt + tl) * 128 + 16 * (4 * w2 + i) + q4) = Sacc[i];
}
__device__ __forceinline__ void ssd_sample_task(LAS unsigned char* lds, CArgs ap, int b, int h) {
    const bf16_t* __restrict__ P = (const bf16_t*)(ap->ws + WS_P);
    const float* __restrict__ dtraw = (const float*)(ap->ws + WS_DT);
    bf16_t* Y = (bf16_t*)ap->out;
    unsigned long long* ssqg = (unsigned long long*)(ap->ws + WS_SSQG);
    const int tid = get_tid(), g = h >> 3, row0 = NT_P + 8 * b;
    LAS float* xs = (LAS float*)lds; LAS float* Bv = xs + 8 * 64; LAS float* Cv = Bv + 8 * 128; LAS float* dts = Cv + 8 * 128; LAS float* dAs = dts + 8;
    const float ah = -__expf(ap->in[13][h]), dtb = ap->in[12][h], Dh = ap->in[14][h];
    const int p = tid >> 3, ng = tid & 7, n0 = 16 * ng;
    f32x4 sv[4];
    { const float* sp = ap->in[2] + ((size_t)(b * 16 + h) * 64 + p) * 128 + n0;
#pragma unroll
      for (int i = 0; i < 4; ++i) sv[i] = *(const f32x4*)(sp + 4 * i); }
    float zv[8];
#pragma unroll
    for (int t = 0; t < 8; ++t) zv[t] = bf1(P[(size_t)(row0 + t) * PP + COL_Z + h * 64 + p]);
    if (tid < 320) {
        int pc, cc; LAS float* dst; int dstride;
        if (tid < 64) { pc = COL_XBC + h * 64 + tid; cc = h * 64 + tid; dst = xs + tid; dstride = 64; }
        else if (tid < 192) { const int n = tid - 64; pc = COL_XBC + 1024 + g * 128 + n; cc = 1024 + g * 128 + n; dst = Bv + n; dstride = 128; }
        else { const int n = tid - 192; pc = COL_XBC + 1280 + g * 128 + n; cc = 1280 + g * 128 + n; dst = Cv + n; dstride = 128; }
        const float* cwp = ap->in[10] + cc; const float w0 = cwp[0], w1 = cwp[CONVD], w2 = cwp[2 * CONVD], w3 = cwp[3 * CONVD], cb = ap->in[11][cc];
        const float* hs = ap->in[3] + (size_t)b * 3 * CONVD + cc;
        float r0 = hs[0], r1 = hs[CONVD], r2 = hs[2 * CONVD];
#pragma unroll
        for (int t = 0; t < 8; ++t) { const float r3 = bf1(P[(size_t)(row0 + t) * PP + pc]); dst[t * dstride] = silu(cb + w0 * r0 + w1 * r1 + w2 * r2 + w3 * r3); r0 = r1; r1 = r2; r2 = r3; }
    } else if (tid < 328) { const int t = tid - 320; const float dt = softplus(dtraw[(size_t)(row0 + t) * 16 + h] + dtb); dts[t] = dt; dAs[t] = __expf(dt * ah); }
    LBAR();
    float S[16];
#pragma unroll
    for (int i = 0; i < 4; ++i) { S[4 * i] = sv[i][0]; S[4 * i + 1] = sv[i][1]; S[4 * i + 2] = sv[i][2]; S[4 * i + 3] = sv[i][3]; }
#pragma unroll
    for (int t = 0; t < 8; ++t) {
        const float dA = dAs[t], xv = xs[t * 64 + p], xdt = xv * dts[t]; float y = 0.f;
#pragma unroll
        for (int i = 0; i < 4; ++i) { const f32x4 bv = *(const LAS f32x4*)(Bv + t * 128 + n0 + 4 * i), cv = *(const LAS f32x4*)(Cv + t * 128 + n0 + 4 * i);
#pragma unroll
            for (int j = 0; j < 4; ++j) { S[4 * i + j] = S[4 * i + j] * dA + xdt * bv[j]; y += S[4 * i + j] * cv[j]; } }
        y = red8(y);
        float ysq = 0.f;
        if (ng == 0) { const float yv = (y + Dh * xv) * silu(zv[t]);
            const bf16_t yb = (bf16_t)(pk2(yv, 0.f) & 0xffffu); Y[(size_t)(row0 + t) * 2048 + h * 64 + p] = yb; ysq = bf1(yb) * bf1(yb); }
        ysq += dppf<0x128>(ysq);
        ysq += __shfl_xor(ysq, 16); ysq += __shfl_xor(ysq, 32);
        if ((tid & 63) == 0) atomicAdd(ssqg + 2 * (size_t)(row0 + t) + g, (unsigned long long)(ysq * 1048576.0f));
    }
    float* so = ap->out + O_SSMS + ((size_t)(b * 16 + h) * 64 + p) * 128 + n0;
#pragma unroll
    for (int i = 0; i < 4; ++i) *(f32x4*)(so + 4 * i) = (f32x4){S[4 * i], S[4 * i + 1], S[4 * i + 2], S[4 * i + 3]};
    LBAR();
}
__device__ __forceinline__ void copy_states(CArgs ap, int part, int nparts) {
    const int tid = get_tid();
    const bf16_t* __restrict__ P = (const bf16_t*)(ap->ws + WS_P);
    float* out = ap->out;
    constexpr int PER = 3 * CONVD + RWP;
    for (int idx = part * 512 + tid; idx < 136 * PER; idx += nparts * 512) {
        const int s = idx / PER, e = idx - s * PER;
        const int last = s < 8 ? s * 2048 + 2047 : NT_P + 8 * (s - 8) + 7;
        if (e < 3 * CONVD) { const int j = e / CONVD, c = e - j * CONVD; const float v = bf1(P[(size_t)(last - 2 + j) * PP + COL_XBC + c]);
            if (s < 8) out[O_CONVP + (size_t)s * 3 * CONVD + e] = v; else out[O_CONVS + (size_t)(s - 8) * 3 * CONVD + e] = v; }
        else { const int c = e - 3 * CONVD; const float v = bf1(P[(size_t)last * PP + COL_RW + c]);
            if (s < 8) out[O_SHIFTP + (size_t)s * RWP + c] = v; else out[O_SHIFTS + (size_t)(s - 8) * RWP + c] = v; }
    }
}
__device__ __forceinline__ void mixer_task(LAS unsigned char* lds, CArgs ap, int task) {
    if (task < 128) { const int b = task >> 4, h = task & 15; rwkv_task<true>(lds, ap, h, b * 2048, 2048, nullptr, nullptr, ap->out + O_WKVP + (size_t)(b * 16 + h) * 4096); }
    else if (task < 256) { const int s = task - 128; ssd_prompt_task(lds, ap, s >> 4, s & 15); }
    else if (task < 256 + 2048) { const int s = task - 256; ssd_sample_task(lds, ap, s >> 4, s & 15); }
    else { const int s = task - 2304, b = s >> 4, h = s & 15;
        rwkv_task<false>(lds, ap, h, NT_P + 8 * b, 8, ap->in[4] + (size_t)(b * 16 + h) * 4096, ap->in[5] + (size_t)b * RWP, ap->out + O_WKVS + (size_t)(b * 16 + h) * 4096); }
}
__device__ __forceinline__ void phase_mixers(LAS unsigned char* lds) {
    const CArgs ap = get_args();
    const int nb = gridDim.x, bid = blockIdx.x;
    if (nb == 256) {
        constexpr int NRS = 0;
        mixer_task(lds, ap, bid);
        if (bid >= 128) { for (int s = bid - 128; s < 4096 - 128 * NRS; s += 128) mixer_task(lds, ap, 256 + s); copy_states(ap, bid - 128, 128); }
        else { for (int k = 0; k < NRS; ++k) mixer_task(lds, ap, 256 + 4096 - 128 * NRS + 128 * k + bid); }
    } else {
        for (int task = bid; task < 4352; task += nb) mixer_task(lds, ap, task);
        copy_states(ap, bid, nb);
    }
}
__device__ __forceinline__ void phase_final() {
    const CArgs ap = get_args();
    const int tid = get_tid(), lane = tid & 63, wave = tid >> 6;
    const int gw = blockIdx.x * 8 + wave, NGW = gridDim.x * 8;
    const float* __restrict__ hbuf = (const float*)(ap->ws + WS_H); const unsigned long long* ssq3 = (const unsigned long long*)(ap->ws + WS_SSQ3); const float* gf = ap->in[35];
    f32x4 gv[4];
#pragma unroll
    for (int j = 0; j < 4; ++j) gv[j] = *(const f32x4*)(gf + 4 * lane + 256 * j);
    for (int m = gw; m < NT; m += 2 * NGW) {
        const int m2 = m + NGW; const bool has2 = m2 < NT; const int m2c = has2 ? m2 : m;
        const float rstd = rsqrtf((float)ssq3[m] * (1.0f / (1024.0f * 1048576.0f)) + 1e-6f), rstd2 = rsqrtf((float)ssq3[m2c] * (1.0f / (1024.0f * 1048576.0f)) + 1e-6f);
        f32x4 v[4], u[4];
#pragma unroll
        for (int j = 0; j < 4; ++j) { v[j] = *(const f32x4*)(hbuf + (size_t)m * DM + 4 * lane + 256 * j); u[j] = *(const f32x4*)(hbuf + (size_t)m2c * DM + 4 * lane + 256 * j); }
#pragma unroll
        for (int j = 0; j < 4; ++j) *(f32x4*)(ap->out + (size_t)m * DM + 4 * lane + 256 * j) = v[j] * rstd * gv[j];
        if (has2) {
#pragma unroll
            for (int j = 0; j < 4; ++j) *(f32x4*)(ap->out + (size_t)m2 * DM + 4 * lane + 256 * j) = u[j] * rstd2 * gv[j]; }
    }
}
#define XB_TMO      128
#define XB_XCNT(j)  (256  + 64 * (j))
#define XB_XSUB(j)  (1280 + 64 * (j))
#define XB_XGEN(j)  (2304 + 64 * (j))
#define XB_TOP      3328
#define XB_TOPGEN   3392
#define XCD_BAR_WORDS 3456
#define XB_SPIN_CAP (1u << 18)

__device__ __forceinline__ unsigned xb_ld(unsigned* p)              { return __hip_atomic_load(p, __ATOMIC_RELAXED, __HIP_MEMORY_SCOPE_AGENT); }
__device__ __forceinline__ unsigned xb_add(unsigned* p, unsigned v) { return __hip_atomic_fetch_add(p, v, __ATOMIC_RELAXED, __HIP_MEMORY_SCOPE_AGENT); }
__device__ __forceinline__ unsigned xb_xcc_id() { return (unsigned)__builtin_amdgcn_s_getreg((3 << 11) | 20) & 0xFu; }
#define XB_SPIN(cond, bar) do { unsigned _sp = 0; while (cond) { __builtin_amdgcn_s_sleep(1); \
    if ((++_sp & 255u) == 0u) { if (xb_ld(&(bar)[XB_TMO])) break; if (_sp > XB_SPIN_CAP) { atomicAdd(&(bar)[XB_TMO], 1u); break; } } } } while (0)

struct XcdBarrier {
    unsigned* bar; unsigned x;
    volatile LAS unsigned* st;
};

__device__ __forceinline__ XcdBarrier xcd_barrier_post(unsigned* bar, volatile LAS unsigned* st) {
    XcdBarrier b; b.bar = bar; b.x = xb_xcc_id(); b.st = st;
    if (threadIdx.x == 0) (void)xb_add(&bar[XB_XCNT(b.x)], 1u);
    return b;
}
__device__ __forceinline__ void xcd_barrier_complete(unsigned* bar, unsigned x, unsigned& nloc, unsigned& nx) {
    const unsigned G = gridDim.x * gridDim.y * gridDim.z;
    unsigned sum, cnt, mine, sp = 0u;
    for (;;) {
        sum = 0u; cnt = 0u; mine = 0u;
#pragma unroll
        for (unsigned j = 0; j < 16; ++j) { const unsigned c = xb_ld(&bar[XB_XCNT(j)]); sum += c; cnt += (c > 0u) ? 1u : 0u; mine = (j == x) ? c : mine; }
        if (sum == G) break;
        __builtin_amdgcn_s_sleep(1);
        if ((++sp & 255u) == 0u) { if (xb_ld(&bar[XB_TMO])) break; if (sp > XB_SPIN_CAP) { atomicAdd(&bar[XB_TMO], 1u); break; } }
    }
    nloc = mine > 0u ? mine : 1u; nx = cnt > 0u ? cnt : 1u;
}

__device__ __forceinline__ void xcd_barrier(const XcdBarrier& b) {
    asm volatile("s_waitcnt vmcnt(0)" ::: "memory");
    __syncthreads();
    if (threadIdx.x == 0) {
        unsigned* bar = b.bar;
        __builtin_amdgcn_s_waitcnt(0);
        unsigned nloc = b.st[0], nx = b.st[1];
        if (nloc == 0u) { xcd_barrier_complete(bar, b.x, nloc, nx); b.st[0] = nloc; b.st[1] = nx; }
        const unsigned old = xb_add(&bar[XB_XSUB(b.x)], 1u);
        const unsigned gen = old / nloc;
        if (old + 1u == (gen + 1u) * nloc) {
            __builtin_amdgcn_fence(__ATOMIC_RELEASE, "agent");
            asm volatile("s_waitcnt vmcnt(0)" ::: "memory");
            const unsigned og = xb_add(&bar[XB_TOP], 1u);
            const unsigned tg = og / nx;
            if (og + 1u == (tg + 1u) * nx) xb_add(&bar[XB_TOPGEN], 1u);
            else XB_SPIN(xb_ld(&bar[XB_TOPGEN]) == tg, bar);
            __builtin_amdgcn_fence(__ATOMIC_ACQUIRE, "agent");
            xb_add(&bar[XB_XGEN(b.x)], 1u);
            asm volatile("s_waitcnt vmcnt(0)" ::: "memory");
        } else {
            XB_SPIN(xb_ld(&bar[XB_XGEN(b.x)]) == gen, bar);
            __builtin_amdgcn_fence(__ATOMIC_ACQUIRE, "agent");
            asm volatile("s_waitcnt vmcnt(0)" ::: "memory");
        }
    }
    __syncthreads();
}


__device__ __forceinline__ void gsync(cg::grid_group& grid) {
    asm volatile("s_waitcnt vmcnt(0) lgkmcnt(0)" ::: "memory");
    grid.sync();
    __builtin_amdgcn_fence(__ATOMIC_ACQUIRE, "agent");
    asm volatile("s_waitcnt vmcnt(0)" ::: "memory");
}
__global__ void __launch_bounds__(512, 2) mega_fwd(Args a_unused) {
    extern __shared__ __attribute__((aligned(16))) unsigned char lds_raw[];
    LAS unsigned char* lds = (LAS unsigned char*)lds_raw;
    cg::grid_group grid = cg::this_grid();
    const int G = gridDim.x, bid = blockIdx.x;
    volatile LAS unsigned* xst = (volatile LAS unsigned*)(lds + 131072 + 64);
    if (threadIdx.x < 2) xst[threadIdx.x] = 0u;
    __syncthreads();
    XcdBarrier xbar = xcd_barrier_post((unsigned*)(get_args()->ws + WS_BAR), xst);
    phase0(lds);
    if (get_args()->ws == nullptr) gsync(grid);
    xcd_barrier(xbar);
    { const CArgs ap = get_args(); unsigned char* ws = ap->ws;
      pg8::Gemm g{(const bf16_t*)(ap->out + O_SSMS), (const bf16_t*)(ws + WS_WIN), NT, NW_IN, 1024}; pg8::StaticOrder S; S.init(NT, NW_IN, G, bid);
      pg8::EpiPlain E{(bf16_t*)(ws + WS_P), PP, 23, (float*)(ws + WS_DT)};
      pg8::gemm_phase<pg8::EpiPlain, pg8::StaticOrder, true, true>(lds, g, S, E); }
    xcd_barrier(xbar);
    phase_alo();
    xcd_barrier(xbar);
    phase_mixers(lds);
    xcd_barrier(xbar);
    { const CArgs ap = get_args(); unsigned char* ws = ap->ws;
      pg8::Gemm g{(const bf16_t*)ap->out, (const bf16_t*)(ws + WS_WOUT), NT, 1024, 2048}; pg8::StaticOrder S; S.init(NT, 1024, G, bid);
      pg8::EpiRes<true> E{(const unsigned long long*)(ws + WS_SSQG), ap->in[0], ap->in[1], (float*)(ws + WS_H), (bf16_t*)(ws + WS_HB), (unsigned long long*)(ws + WS_SSQ1)};
      pg8::gemm_phase<pg8::EpiRes<true>, pg8::StaticOrder, true, true>(lds, g, S, E); }
    { const int rem = ((NT / 256) * 4) % G; phase0b(lds, (G >= 64 && rem > 0 && rem < G - 32) ? rem : 0); }
    xcd_barrier(xbar);
    { const CArgs ap = get_args(); unsigned char* ws = ap->ws;
      pg8::Gemm g{(const bf16_t*)(ws + WS_HB), (const bf16_t*)(ws + WS_WGU), NT, 2 * DFF, 1024}; pg8::StaticOrder S; S.init(NT, 2 * DFF, G, bid);
      pg8::EpiGU E{(bf16_t*)(ws + WS_FF), (const unsigned long long*)(ws + WS_SSQ1)};
      pg8::gemm_phase<pg8::EpiGU, pg8::StaticOrder, true, true>(lds, g, S, E); }
    xcd_barrier(xbar);
    { const CArgs ap = get_args(); unsigned char* ws = ap->ws; float* hbuf = (float*)(ws + WS_H);
      pg8::Gemm g{(const bf16_t*)(ws + WS_FF), (const bf16_t*)(ws + WS_WDOWN), NT, 1024, DFF}; pg8::StaticOrder S; S.init(NT, 1024, G, bid);
      pg8::EpiRes<false> E{nullptr, hbuf, hbuf + (size_t)NT_P * 1024, hbuf, (bf16_t*)(ws + WS_HB), (unsigned long long*)(ws + WS_SSQ2)};
      pg8::gemm_phase<pg8::EpiRes<false>, pg8::StaticOrder, true, true>(lds, g, S, E); }
    { const int rem_ = ((NT / 256) * 4) % G; const int ppf = (G >= 64 && rem_ > 0 && rem_ < G - 32) ? rem_ : 0;
      if (bid >= ppf) { const CArgs ap = get_args(); unsigned char* ws = ap->ws;
      pg8::Gemm g{(const bf16_t*)(ws + WS_PB), (const bf16_t*)(ws + WS_WPLP), NT, 1024, 256}; pg8::StaticOrder S; S.init(NT, 1024, G - ppf, bid - ppf);
      pg8::EpiPlain E{(bf16_t*)ap->out, 1024, 4, nullptr};
      pg8::gemm_phase<pg8::EpiPlain, pg8::StaticOrder, true, true>(lds, g, S, E); } }
    xcd_barrier(xbar);
    { const CArgs ap = get_args(); unsigned char* ws = ap->ws;
      pg8::Gemm g{(const bf16_t*)(ws + WS_HB), (const bf16_t*)(ws + WS_WPLG), NT, 1024, 1024}; pg8::StaticOrder S; S.init(NT, 1024, G, bid);
      pg8::EpiPle E{(float*)(ws + WS_H), (const bf16_t*)ap->out, (const unsigned long long*)(ws + WS_SSQ2), (unsigned long long*)(ws + WS_SSQ3)};
      pg8::gemm_phase<pg8::EpiPle, pg8::StaticOrder, true, true>(lds, g, S, E); }
    xcd_barrier(xbar);
    phase_final();
}

extern "C" void kernel_launch(void* const* d_in, const int* in_sizes, int n_in, void* d_out, int out_size, void* d_ws, size_t ws_size, hipStream_t stream) {
    static int grid_blocks = 0;
    if (grid_blocks == 0) {
        if (n_in != 36 || out_size != (int)O_END || ws_size < 256 * MiB) { fprintf(stderr, "kernel_launch: unexpected problem shape (n_in %d out %d ws %zu)\n", n_in, out_size, ws_size); grid_blocks = -1; return; }
        int dev = 0, cus = 0, per_cu = 0;
        hipGetDevice(&dev);
        hipDeviceGetAttribute(&cus, hipDeviceAttributeMultiprocessorCount, dev);
        if (hipFuncSetAttribute((const void*)mega_fwd, hipFuncAttributeMaxDynamicSharedMemorySize, LDS_BYTES) != hipSuccess) { fprintf(stderr, "kernel_launch: hipFuncSetAttribute failed\n"); grid_blocks = -1; return; }
        if (hipOccupancyMaxActiveBlocksPerMultiprocessor(&per_cu, (const void*)mega_fwd, 512, LDS_BYTES) != hipSuccess || per_cu < 1) per_cu = 1;
        (void)hipGetLastError();
        grid_blocks = cus * per_cu;
    }
    if (grid_blocks < 0) return;
    hipMemsetAsync(d_ws, 0, WS_ZERO_BYTES, stream);
    Args a{};
    for (int i = 0; i < 36; ++i) a.in[i] = (const float*)d_in[i];
    a.out = (float*)d_out; a.ws = (unsigned char*)d_ws;
    void* args[] = {&a};
    hipError_t e = hipLaunchCooperativeKernel((const void*)mega_fwd, dim3(grid_blocks), dim3(512), args, LDS_BYTES, stream);
    if (e != hipSuccess) fprintf(stderr, "cooperative launch failed: %s (grid %d)\n", hipGetErrorString(e), grid_blocks);
}
```

```cpp
#include <hip/hip_runtime.h>
#include <hip/hip_cooperative_groups.h>
#include <cstdio>
#include <cstdint>
namespace cg = cooperative_groups;
namespace pg8 {
#define PG8_LAS __attribute__((address_space(3)))
typedef unsigned short bf16_t;
typedef short bf16x8 __attribute__((ext_vector_type(8)));
typedef float f32x4 __attribute__((ext_vector_type(4)));
typedef unsigned u32x4 __attribute__((ext_vector_type(4)));
constexpr int BM = 256, BK = 64, HALF = 128, HTB = HALF * BK * 2  , STAGE_BYTES = 8 * HTB, NXCD = 8, WGM = 8;

__host__ __device__ __forceinline__ int lds_byte(int r, int c) { const int st = (r >> 4) * 2 + (c >> 5), rr = r & 15, cc = c & 31, ob = rr * 64 + cc * 2; return st * 1024 + (ob ^ (((ob >> 9) & 1) << 5)); }
__host__ __device__ __forceinline__ void stage_rc(int b, int& R, int& C) { const int st = b / 1024, sb = b % 1024, swz = sb ^ (((sb >> 9) & 1) << 5); R = (st >> 1) * 16 + swz / 64; C = (st & 1) * 32 + (swz % 64) / 2; }
__host__ __device__ __forceinline__ int perm32(int rho) { const int n = rho >> 4, i = rho & 15; return 8 * (i >> 2) + 4 * n + (i & 3); }

struct Unit { int pm, pn; };
struct Gemm { const bf16_t* A; const bf16_t* Bt; int M, N, K; };

struct StaticOrder {
    int nM, nN, nwg, G, c;
    __host__ __device__ void init(int M, int N, int G_, int c_) { nM = M / BM; nN = N / BM; nwg = nM * nN; G = G_; c = c_; }
    __host__ __device__ bool next(int i, Unit& u) const {
        const long L = (long)i * G + c; if (L >= nwg) return false;
        int wgid = (int)L; { const int q = nwg / NXCD, r = nwg % NXCD, xcd = wgid % NXCD, off = wgid / NXCD; wgid = (xcd < r ? xcd * (q + 1) : r * (q + 1) + (xcd - r) * q) + off; }
        const int nig = WGM * nN, gid = wgid / nig, fm = gid * WGM, gsz = (nM - fm) < WGM ? (nM - fm) : WGM;
        u.pm = fm + ((wgid % nig) % gsz); u.pn = (wgid % nig) / gsz; return true;
    }
    __device__ __forceinline__ void a_ready(const Unit&) const {}
    __device__ __forceinline__ void done(const Unit&) const {}
};


template <class Epi, class Sched, bool ALIGN_EPI = false, bool SP2 = false>
__device__ __forceinline__ void gemm_phase(PG8_LAS unsigned char* lds, const Gemm g, const Sched& S, const Epi& E) {
    int tid_ = threadIdx.x; asm volatile("" : "+v"(tid_));
    const int tid = tid_, wid = __builtin_amdgcn_readfirstlane(tid >> 6), lane = tid & 63, wr = wid >> 2, wc = wid & 3, fr = lane & 15, fq = lane >> 4;
    const int K = g.K, nt = K / BK;
    unsigned voffA[2], voffB[2];
#pragma unroll
    for (int i = 0; i < 2; ++i) { int R, C; stage_rc(tid * 16 + i * 8192, R, C); const int Rb = Epi::PERM ? ((R & ~31) + perm32(R & 31)) : R;
        voffA[i] = (unsigned)(R * K + C) * 2u; voffB[i] = (unsigned)(Rb * K + C) * 2u; }
    const size_t kstep = (size_t)(BK * 2);
    const size_t hstep = (size_t)HALF * K * 2;
    const size_t tstep = 2 * hstep;
    const unsigned ldsw = (unsigned)wid * 1024u;
    const int aoff = lds_byte(wr * 64 + fr, fq * 8), boff = lds_byte(wc * 32 + fr, fq * 8);
#define PG8_SA(b, h) (((b) * 2 + (h)) * HTB)
#define PG8_SB(b, h) ((4 + (b) * 2 + (h)) * HTB)
#define PG8_STAGE(bufoff, gbase, voff) do { _Pragma("unroll") for (int _i = 0; _i < 2; ++_i) \
        __builtin_amdgcn_global_load_lds((const unsigned*)((const char*)(gbase) + (voff)[_i]), (PG8_LAS unsigned*)(lds + (bufoff) + ldsw + _i * 8192), 16, 0, 0); } while (0)
#define PG8_LDA(dst, b, h) do { _Pragma("unroll") for (int m = 0; m < 4; ++m) _Pragma("unroll") for (int k = 0; k < 2; ++k) dst[m][k] = *(const PG8_LAS bf16x8*)(lds + PG8_SA(b, h) + aoff + m * 2048 + k * 1024); } while (0)
#define PG8_LDB(dst, b, h) do { _Pragma("unroll") for (int n = 0; n < 2; ++n) _Pragma("unroll") for (int k = 0; k < 2; ++k) dst[n][k] = *(const PG8_LAS bf16x8*)(lds + PG8_SB(b, h) + boff + n * 2048 + k * 1024); } while (0)
#define PG8_MMA(ai, bj, At, Bt) do { __builtin_amdgcn_s_setprio(1); _Pragma("unroll") for (int m = 0; m < 4; ++m) _Pragma("unroll") for (int n = 0; n < 2; ++n) _Pragma("unroll") for (int k = 0; k < 2; ++k) \
        acc[ai][bj][m][n] = __builtin_amdgcn_mfma_f32_16x16x32_bf16(Bt[n][k], At[m][k], acc[ai][bj][m][n], 0, 0, 0); __builtin_amdgcn_s_setprio(0); } while (0)
#define PG8_WAIT_V(n) asm volatile("s_waitcnt vmcnt(" #n ")" ::: "memory")
#define PG8_WAIT_L(n) asm volatile("s_waitcnt lgkmcnt(" #n ")" ::: "memory")
#define PG8_BAR __builtin_amdgcn_s_barrier()
#define PG8_SCHED __builtin_amdgcn_sched_barrier(0)
    Unit cur, nxt; int ui = 0;
    if (!S.next(0, cur)) return;
    f32x4 acc[2][2][4][2];
#pragma unroll
    for (int a = 0; a < 2; ++a)
#pragma unroll
        for (int b = 0; b < 2; ++b)
#pragma unroll
            for (int m = 0; m < 4; ++m)
#pragma unroll
                for (int n = 0; n < 2; ++n) acc[a][b][m][n] = (f32x4){0.f, 0.f, 0.f, 0.f};
    bf16x8 At[4][2], B0[2][2], B1[2][2];
    const char* cA = (const char*)g.A + (size_t)cur.pm * tstep; const char* cB = (const char*)g.Bt + (size_t)cur.pn * tstep;
    S.a_ready(cur);
    if constexpr (SP2) {
        PG8_STAGE(PG8_SB(0, 0), cB, voffB); PG8_STAGE(PG8_SB(0, 1), cB + hstep, voffB); PG8_STAGE(PG8_SA(0, 0), cA, voffA); PG8_STAGE(PG8_SA(0, 1), cA + hstep, voffA);
        if (wr == 1) PG8_BAR;
        PG8_WAIT_V(2); PG8_BAR;
        PG8_STAGE(PG8_SB(1, 0), cB + kstep, voffB); PG8_STAGE(PG8_SA(1, 0), cA + kstep, voffA); PG8_STAGE(PG8_SB(1, 1), cB + hstep + kstep, voffB);
        PG8_WAIT_V(6); PG8_BAR;
    } else {
        PG8_STAGE(PG8_SB(0, 0), cB, voffB); PG8_STAGE(PG8_SA(0, 0), cA, voffA); PG8_STAGE(PG8_SB(0, 1), cB + hstep, voffB); PG8_STAGE(PG8_SA(0, 1), cA + hstep, voffA);
        if (wr == 1) PG8_BAR;
        PG8_WAIT_V(4); PG8_BAR;
        PG8_STAGE(PG8_SB(1, 0), cB + kstep, voffB); PG8_STAGE(PG8_SA(1, 0), cA + kstep, voffA); PG8_STAGE(PG8_SB(1, 1), cB + hstep + kstep, voffB);
        PG8_WAIT_V(6); PG8_BAR;
    }
    for (;;) {
        const bool has_next = S.next(ui + 1, nxt);
        const char* nA = has_next ? (const char*)g.A + (size_t)nxt.pm * tstep : cA; const char* nB = has_next ? (const char*)g.Bt + (size_t)nxt.pn * tstep : cB;
        for (int t = 0; t < nt; t += 2) {
            const bool last = (t == nt - 2);
            const char* a1 = cA + (size_t)(t + 1) * kstep;
            const char* a2 = last ? nA : cA + (size_t)(t + 2) * kstep; const char* b2 = last ? nB : cB + (size_t)(t + 2) * kstep;
            const char* a3 = a2 + kstep; const char* b3 = b2 + kstep;
            if (last && has_next) S.a_ready(nxt);
            if constexpr (SP2) {
            PG8_LDB(B0, 0, 0); PG8_LDB(B1, 0, 1); PG8_SCHED; PG8_LDA(At, 0, 0); PG8_STAGE(PG8_SA(1, 1), a1 + hstep, voffA);
            PG8_WAIT_V(8); PG8_WAIT_L(0); PG8_BAR; PG8_MMA(0, 0, At, B0); PG8_MMA(0, 1, At, B1); PG8_BAR; PG8_SCHED;
            PG8_LDA(At, 0, 1); PG8_STAGE(PG8_SB(0, 0), b2, voffB); PG8_STAGE(PG8_SB(0, 1), b2 + hstep, voffB); PG8_STAGE(PG8_SA(0, 0), a2, voffA);
            PG8_WAIT_V(8); PG8_WAIT_L(0); PG8_BAR; PG8_MMA(1, 0, At, B0); PG8_MMA(1, 1, At, B1); PG8_BAR; PG8_SCHED;
            PG8_LDB(B0, 1, 0); PG8_LDB(B1, 1, 1); PG8_SCHED; PG8_LDA(At, 1, 0); PG8_STAGE(PG8_SA(0, 1), a2 + hstep, voffA);
            PG8_WAIT_V(8); PG8_WAIT_L(0); PG8_BAR; PG8_MMA(0, 0, At, B0); PG8_MMA(0, 1, At, B1); PG8_BAR; PG8_SCHED;
            PG8_LDA(At, 1, 1); PG8_STAGE(PG8_SB(1, 0), b3, voffB); PG8_STAGE(PG8_SB(1, 1), b3 + hstep, voffB); PG8_STAGE(PG8_SA(1, 0), a3, voffA);
            PG8_WAIT_V(8); PG8_WAIT_L(0); PG8_BAR; PG8_MMA(1, 0, At, B0); PG8_MMA(1, 1, At, B1); PG8_BAR; PG8_SCHED;
            if constexpr (Epi::KSCALE) { const int kd = (t + 2) * BK; if (kd == 512 || kd == 1024) E.kscale(acc, cur, kd, wr, fr); }
            } else {
            PG8_LDB(B0, 0, 0); PG8_SCHED; PG8_LDA(At, 0, 0); PG8_STAGE(PG8_SA(1, 1), a1 + hstep, voffA);
            PG8_WAIT_L(8); PG8_BAR; PG8_WAIT_L(0); PG8_MMA(0, 0, At, B0); PG8_BAR; PG8_SCHED;
            PG8_LDB(B1, 0, 1); PG8_STAGE(PG8_SB(0, 0), b2, voffB);
            PG8_BAR; PG8_WAIT_L(0); PG8_MMA(0, 1, At, B1); PG8_BAR;
            PG8_LDA(At, 0, 1); PG8_STAGE(PG8_SA(0, 0), a2, voffA);
            PG8_BAR; PG8_WAIT_L(0); PG8_MMA(1, 0, At, B0); PG8_BAR; PG8_SCHED;
            PG8_STAGE(PG8_SB(0, 1), b2 + hstep, voffB);
            PG8_WAIT_V(6); PG8_BAR; PG8_MMA(1, 1, At, B1); PG8_BAR;
            PG8_LDB(B0, 1, 0); PG8_SCHED; PG8_LDA(At, 1, 0); PG8_STAGE(PG8_SA(0, 1), a2 + hstep, voffA);
            PG8_WAIT_L(8); PG8_BAR; PG8_WAIT_L(0); PG8_MMA(0, 0, At, B0); PG8_BAR; PG8_SCHED;
            PG8_LDB(B1, 1, 1); PG8_STAGE(PG8_SB(1, 0), b3, voffB);
            PG8_BAR; PG8_WAIT_L(0); PG8_MMA(0, 1, At, B1); PG8_BAR;
            PG8_LDA(At, 1, 1); PG8_STAGE(PG8_SA(1, 0), a3, voffA);
            PG8_BAR; PG8_WAIT_L(0); PG8_MMA(1, 0, At, B0); PG8_BAR; PG8_SCHED;
            PG8_STAGE(PG8_SB(1, 1), b3 + hstep, voffB);
            PG8_WAIT_V(6); PG8_BAR; PG8_MMA(1, 1, At, B1); PG8_BAR;
            }
        }
        if constexpr (ALIGN_EPI) { if (wr == 0) PG8_BAR; }
        if constexpr (!Epi::AFTER_DRAIN) { E(acc, cur, wr, wc, fr, fq); S.done(cur); }
        if (!has_next) break;
#pragma unroll
        for (int a = 0; a < 2; ++a)
#pragma unroll
            for (int b = 0; b < 2; ++b)
#pragma unroll
                for (int m = 0; m < 4; ++m)
#pragma unroll
                    for (int n = 0; n < 2; ++n) acc[a][b][m][n] = (f32x4){0.f, 0.f, 0.f, 0.f};
        cur = nxt; cA = nA; cB = nB; ++ui;
        if constexpr (ALIGN_EPI) { if (wr == 1) PG8_BAR; }
    }
    PG8_WAIT_V(0);
    if constexpr (!ALIGN_EPI) { if (wr == 0) PG8_BAR; }
    PG8_BAR;
    if constexpr (Epi::AFTER_DRAIN) { E.fused(acc, cur, wr, wc, fr, fq, lds, wid, lane); S.done(cur); }
#undef PG8_SA
#undef PG8_SB
#undef PG8_STAGE
#undef PG8_LDA
#undef PG8_LDB
#undef PG8_MMA
#undef PG8_WAIT_V
#undef PG8_WAIT_L
#undef PG8_BAR
#undef PG8_SCHED
}
}
namespace pg8 {
__device__ __forceinline__ unsigned cvt_pk_bf16(float lo, float hi) { unsigned r; asm volatile("v_cvt_pk_bf16_f32 %0, %1, %2" : "=v"(r) : "v"(lo), "v"(hi)); return r; }
__device__ __forceinline__ u32x4 pack8(f32x4 v0, f32x4 v1) { u32x4 w; w.x = cvt_pk_bf16(v0[0], v0[1]); w.y = cvt_pk_bf16(v0[2], v0[3]); w.z = cvt_pk_bf16(v1[0], v1[1]); w.w = cvt_pk_bf16(v1[2], v1[3]); return w; }
__device__ __forceinline__ float sq4(f32x4 v) { return (v[0] * v[0] + v[1] * v[1]) + (v[2] * v[2] + v[3] * v[3]); }
constexpr int T_PROMPT = 16384;
struct EpiPlain {
    static constexpr bool PERM = true, AFTER_DRAIN = false, KSCALE = false;
    bf16_t* O; int ldc; int nfull; float* dt;
    __device__ __forceinline__ void operator()(const f32x4 (&acc)[2][2][4][2], const Unit& u, int wr, int wc, int fr, int fq) const {
        const int row0 = u.pm * BM + wr * 64 + fr;
        if (u.pn < nfull) {
            const int col0 = u.pn * BM + wc * 32 + 8 * fq;
#pragma unroll
            for (int ai = 0; ai < 2; ++ai)
#pragma unroll
                for (int m = 0; m < 4; ++m) { bf16_t* rowp = O + (size_t)(row0 + ai * HALF + m * 16) * ldc + col0;
#pragma unroll
                    for (int bj = 0; bj < 2; ++bj) *(u32x4*)(rowp + bj * HALF) = pack8(acc[ai][bj][m][0], acc[ai][bj][m][1]); }
        } else if (dt != nullptr && wc == 0 && fq < 2) {
#pragma unroll
            for (int ai = 0; ai < 2; ++ai)
#pragma unroll
                for (int m = 0; m < 4; ++m) { float* d = dt + (size_t)(row0 + ai * HALF + m * 16) * 16 + 8 * fq; *(f32x4*)d = acc[ai][0][m][0]; *(f32x4*)(d + 4) = acc[ai][0][m][1]; }
        }
    }
};
template <bool KS> struct EpiRes {
    static constexpr bool PERM = true, AFTER_DRAIN = false, KSCALE = KS;
    const unsigned long long* ssqg;
    __device__ __forceinline__ void kscale(f32x4 (&acc)[2][2][4][2], const Unit& u, int kd, int wr, int fr) const {
        const int row0 = u.pm * BM + wr * 64 + fr;
#pragma unroll
        for (int ai = 0; ai < 2; ++ai)
#pragma unroll
            for (int m = 0; m < 4; ++m) { const int row = row0 + ai * HALF + m * 16;
                const float r0 = rsqrtf((float)ssqg[2 * row] * (1.0f / (512.0f * 1048576.0f)) + 1e-6f), r1 = rsqrtf((float)ssqg[2 * row + 1] * (1.0f / (512.0f * 1048576.0f)) + 1e-6f);
                const float sc = (kd == 512) ? r0 / r1 : r1;
#pragma unroll
                for (int bj = 0; bj < 2; ++bj)
#pragma unroll
                    for (int n = 0; n < 2; ++n) acc[ai][bj][m][n] = acc[ai][bj][m][n] * sc; }
    }
    const float* base_p; const float* base_s; float* out; bf16_t* outb; unsigned long long* ssq;
    __device__ __forceinline__ void operator()(const f32x4 (&acc)[2][2][4][2], const Unit& u, int wr, int wc, int fr, int fq) const {
        const int row0 = u.pm * BM + wr * 64 + fr, col0 = u.pn * BM + wc * 32 + 8 * fq;
#pragma unroll
        for (int ai = 0; ai < 2; ++ai)
#pragma unroll
            for (int m = 0; m < 4; ++m) { const int row = row0 + ai * HALF + m * 16;
                const float* bp = (row < T_PROMPT) ? base_p + (size_t)row * 1024 : base_s + (size_t)(row - T_PROMPT) * 1024;
                float* op = out + (size_t)row * 1024; bf16_t* ob = outb + (size_t)row * 1024; float s = 0.f;
#pragma unroll
                for (int bj = 0; bj < 2; ++bj) { const int c = col0 + bj * HALF;
                    const f32x4 v0 = acc[ai][bj][m][0] + *(const f32x4*)(bp + c), v1 = acc[ai][bj][m][1] + *(const f32x4*)(bp + c + 4);
                    *(f32x4*)(op + c) = v0; *(f32x4*)(op + c + 4) = v1; *(u32x4*)(ob + c) = pack8(v0, v1); s += sq4(v0) + sq4(v1); }
                s += __shfl_xor(s, 16); s += __shfl_xor(s, 32);
                if (fq == 0) atomicAdd(ssq + row, (unsigned long long)(s * 1048576.0f)); }
    }
};
struct EpiGU {
    static constexpr bool PERM = true, AFTER_DRAIN = false, KSCALE = false;
    bf16_t* H; const unsigned long long* ssq;
    __device__ __forceinline__ void operator()(const f32x4 (&acc)[2][2][4][2], const Unit& u, int wr, int wc, int fr, int fq) const {
        const int row0 = u.pm * BM + wr * 64 + fr, col0 = u.pn * HALF + wc * 32 + 8 * fq;
#pragma unroll
        for (int ai = 0; ai < 2; ++ai)
#pragma unroll
            for (int m = 0; m < 4; ++m) { const int row = row0 + ai * HALF + m * 16;
                const float rstd = rsqrtf((float)ssq[row] * (1.0f / (1024.0f * 1048576.0f)) + 1e-6f);
                f32x4 o[2];
#pragma unroll
                for (int n = 0; n < 2; ++n) { const f32x4 g = acc[ai][0][m][n] * rstd, uu = acc[ai][1][m][n] * rstd;
#pragma unroll
                    for (int j = 0; j < 4; ++j) o[n][j] = g[j] * __builtin_amdgcn_rcpf(1.0f + __expf(-g[j])) * uu[j]; }
                *(u32x4*)(H + (size_t)row * 2816 + col0) = pack8(o[0], o[1]); }
    }
};
struct EpiPle {
    static constexpr bool PERM = true, AFTER_DRAIN = false, KSCALE = false;
    float* h; const bf16_t* pp; const unsigned long long* ssq2; unsigned long long* ssq3;
    __device__ __forceinline__ void operator()(const f32x4 (&acc)[2][2][4][2], const Unit& u, int wr, int wc, int fr, int fq) const {
        const int row0 = u.pm * BM + wr * 64 + fr, col0 = u.pn * BM + wc * 32 + 8 * fq;
#pragma unroll
        for (int ai = 0; ai < 2; ++ai)
#pragma unroll
            for (int m = 0; m < 4; ++m) { const int row = row0 + ai * HALF + m * 16;
                const float rstd = rsqrtf((float)ssq2[row] * (1.0f / (1024.0f * 1048576.0f)) + 1e-6f);
                float* hp = h + (size_t)row * 1024; const bf16_t* pr = pp + (size_t)row * 1024; float s = 0.f;
#pragma unroll
                for (int bj = 0; bj < 2; ++bj) { const int c = col0 + bj * HALF;
                    const u32x4 pw = *(const u32x4*)(pr + c);
                    f32x4 p0, p1; p0[0] = __uint_as_float(pw.x << 16); p0[1] = __uint_as_float(pw.x & 0xffff0000u); p0[2] = __uint_as_float(pw.y << 16); p0[3] = __uint_as_float(pw.y & 0xffff0000u);
                    p1[0] = __uint_as_float(pw.z << 16); p1[1] = __uint_as_float(pw.z & 0xffff0000u); p1[2] = __uint_as_float(pw.w << 16); p1[3] = __uint_as_float(pw.w & 0xffff0000u);
                    f32x4 v0 = *(const f32x4*)(hp + c), v1 = *(const f32x4*)(hp + c + 4);
                    const f32x4 a0 = acc[ai][bj][m][0] * rstd, a1 = acc[ai][bj][m][1] * rstd;
#pragma unroll
                    for (int j = 0; j < 4; ++j) { v0[j] += p0[j] * __builtin_amdgcn_rcpf(1.0f + __expf(-a0[j])); v1[j] += p1[j] * __builtin_amdgcn_rcpf(1.0f + __expf(-a1[j])); }
                    *(f32x4*)(hp + c) = v0; *(f32x4*)(hp + c + 4) = v1; s += sq4(v0) + sq4(v1); }
                s += __shfl_xor(s, 16); s += __shfl_xor(s, 32);
                if (fq == 0) atomicAdd(ssq3 + row, (unsigned long long)(s * 1048576.0f)); }
    }
};
}
#define LAS __attribute__((address_space(3)))
typedef pg8::bf16_t bf16_t;
typedef pg8::bf16x8 bf16x8;
typedef pg8::f32x4 f32x4;
typedef pg8::u32x4 u32x4;
typedef unsigned u32x2 __attribute__((ext_vector_type(2)));

constexpr int NT_P = 16384, NT_S = 1024, NT = NT_P + NT_S, DM = 1024;
constexpr int PP = 5888;
constexpr int NW_IN = 6144;
constexpr int DFF = 2816, PLE = 256, RWP = 3328, CONVD = 1536;
constexpr int COL_Z = 0, COL_XBC = 1024, COL_RW = 2560;
constexpr size_t MiB = 1u << 20;
constexpr size_t WS_SSQ1 = 0, WS_SSQ2 = 192 * 1024, WS_SSQ3 = 384 * 1024, WS_SSQG = 576 * 1024, WS_BAR = 896 * 1024, WS_ZERO_BYTES = 1 * MiB;
constexpr size_t WS_WIN = 1 * MiB, WS_WOUT = 13 * MiB, WS_WGU = 17 * MiB, WS_WDOWN = 28 * MiB, WS_WPLG = 34 * MiB, WS_WPLP = 36 * MiB;
constexpr size_t WS_W2T = 37 * MiB, WS_A2T = WS_W2T + 128 * 1024, WS_G2T = WS_W2T + 256 * 1024;
constexpr size_t WS_P = 40 * MiB;
constexpr size_t WS_ALO = 247 * MiB;
constexpr size_t WS_DT = 236 * MiB, WS_PB = 238 * MiB;
constexpr size_t WS_H = 40 * MiB, WS_HB = 108 * MiB, WS_FF = 142 * MiB;
static_assert(WS_P + (size_t)NT * PP * 2 <= WS_DT && WS_PB + (size_t)NT * PLE * 2 <= 256 * MiB && WS_FF + (size_t)NT * DFF * 2 <= WS_DT, "ws map");
constexpr size_t O_YP = 0, O_YS = 16777216, O_SSMP = 17825792, O_CONVP = 18874368, O_WKVP = 18911232, O_SHIFTP = 19435520,
                 O_SSMS = 19462144, O_CONVS = 36239360, O_WKVS = 36829184, O_SHIFTS = 45217792, O_END = 45643776;
constexpr int LDS_BYTES = 135168;

__device__ __forceinline__ float bflo(unsigned u) { return __uint_as_float(u << 16); }
__device__ __forceinline__ float bfhi(unsigned u) { return __uint_as_float(u & 0xffff0000u); }
__device__ __forceinline__ float bf1(bf16_t u) { return __uint_as_float(((unsigned)u) << 16); }
__device__ __forceinline__ unsigned pk2(float lo, float hi) { return pg8::cvt_pk_bf16(lo, hi); }
__device__ __forceinline__ float sigm(float x) { return __builtin_amdgcn_rcpf(1.0f + __expf(-x)); }
__device__ __forceinline__ float silu(float x) { return x * __builtin_amdgcn_rcpf(1.0f + __expf(-x)); }
__device__ __forceinline__ float tanh_fast(float x) { return 1.0f - 2.0f * __builtin_amdgcn_rcpf(__expf(2.0f * x) + 1.0f); }
__device__ __forceinline__ float softplus(float x) { const float e = __expf(-fabsf(x)); const float l = (e < 0.01f) ? e * (1.0f - e * (0.5f - e * 0.33333333f)) : __logf(1.0f + e); return fmaxf(x, 0.f) + l; }
__device__ __forceinline__ float wave_sum(float v) {
#pragma unroll
    for (int o = 1; o < 64; o <<= 1) v += __shfl_xor(v, o);
    return v;
}
template <int CTRL> __device__ __forceinline__ float dppf(float x) { return __int_as_float(__builtin_amdgcn_update_dpp(0, __float_as_int(x), CTRL, 0xf, 0xf, true)); }
__device__ __forceinline__ float half_sum(float v) {
    v += dppf<0xB1>(v); v += dppf<0x4E>(v); v += dppf<0x141>(v); v += dppf<0x140>(v);
    const float s0 = __int_as_float(__builtin_amdgcn_readlane(__float_as_int(v), 0)), s1 = __int_as_float(__builtin_amdgcn_readlane(__float_as_int(v), 16));
    const float s2 = __int_as_float(__builtin_amdgcn_readlane(__float_as_int(v), 32)), s3 = __int_as_float(__builtin_amdgcn_readlane(__float_as_int(v), 48));
    return ((threadIdx.x & 32) == 0) ? (s0 + s1) : (s2 + s3);
}
__device__ __forceinline__ float red8(float x) {
    x += dppf<0xB1>(x);
    x += dppf<0x4E>(x);
    x += dppf<0x141>(x);
    return x;
}
__device__ __forceinline__ float red16(float x) {
    x += dppf<0xB1>(x); x += dppf<0x4E>(x); x += dppf<0x141>(x); x += dppf<0x140>(x);
    return x;
}
typedef float f32x2v __attribute__((ext_vector_type(2)));
typedef _Float16 h2v __attribute__((ext_vector_type(2)));
typedef __fp16 fh2v __attribute__((ext_vector_type(2)));
__device__ __forceinline__ h2v toh2(unsigned u) { return __builtin_bit_cast(h2v, u); }
#define LBAR() asm volatile("s_waitcnt lgkmcnt(0)\n\ts_barrier" ::: "memory")
#define LDS_WAIT() asm volatile("s_waitcnt lgkmcnt(0)" ::: "memory")
__device__ __forceinline__ bf16x8 ldfrag(const LAS unsigned char* p) { return *(const LAS bf16x8*)p; }
__device__ __forceinline__ bf16x8 frag_from_f32(const LAS float* p) {
    const f32x4 a = *(const LAS f32x4*)p, b = *(const LAS f32x4*)(p + 4);
    return __builtin_bit_cast(bf16x8, pg8::pack8(a, b));
}
#define MFMA16(X, Y, ACC) __builtin_amdgcn_mfma_f32_16x16x32_bf16((X), (Y), (ACC), 0, 0, 0)

struct Args {
    const float* in[36]; float* out; unsigned char* ws;
};
typedef const __attribute__((address_space(4))) Args* CArgs;
__device__ __forceinline__ CArgs get_args() { CArgs p = (CArgs)__builtin_amdgcn_kernarg_segment_ptr(); asm volatile("" : "+s"(p)); return p; }
__device__ __forceinline__ int get_tid() { int t = threadIdx.x; asm volatile("" : "+v"(t)); return t; }

__device__ __forceinline__ int map_row(int code, int n) {
    if (code == 1) return n < 2560 ? n : (n < 2576 ? 5888 + (n - 2560) : n - 16);
    if (code == 2) return (n >> 7) * 256 + (n & 127);
    if (code == 3) return (n >> 7) * 256 + 128 + (n & 127);
    return n;
}
__device__ __forceinline__ void transpose_item(const float* __restrict__ W, int K, int N, bf16_t* WT, const float* __restrict__ gain, int gain_n, int code, LAS float* scr, int item, int lane) {
    const int nblk = (N + 31) / 32, kb = item / nblk, nb = item % nblk, k0 = 64 * kb, n0 = 32 * nb;
#pragma unroll 8
    for (int i = 0; i < 32; ++i) { const int kk = 2 * i + (lane >> 5), n = n0 + (lane & 31);
        float v = (n < N) ? W[(size_t)(k0 + kk) * N + n] : 0.f;
        if (gain != nullptr && (k0 + kk) < gain_n) v *= gain[k0 + kk];
        scr[kk * 33 + (lane & 31)] = v; }
    LDS_WAIT(); asm volatile("" ::: "memory");
    const int c = lane & 7;
#pragma unroll
    for (int j = 0; j < 4; ++j) { const int nl = (lane >> 3) + 8 * j, n = n0 + nl; const LAS float* s = scr + (8 * c) * 33 + nl;
        u32x4 o; o.x = pk2(s[0 * 33], s[1 * 33]); o.y = pk2(s[2 * 33], s[3 * 33]); o.z = pk2(s[4 * 33], s[5 * 33]); o.w = pk2(s[6 * 33], s[7 * 33]);
        if (n < N) *(u32x4*)(WT + (size_t)map_row(code, n) * K + k0 + 8 * c) = o; }
    LDS_WAIT(); asm volatile("" ::: "memory");
}
__device__ __forceinline__ void phase0b(LAS unsigned char* lds, int first_blk) {
    const CArgs ap = get_args();
    const int tid = get_tid(), lane = tid & 63, wave = tid >> 6;
    if ((int)blockIdx.x < first_blk) return;
    LAS float* scr = (LAS float*)(lds + wave * 16384);
    const int gw = ((int)blockIdx.x - first_blk) * 8 + wave, NGW = ((int)gridDim.x - first_blk) * 8;
    unsigned char* ws = ap->ws;
    int base = 0;
#define DO_MAT(SRC, K_, N_, DST, GAIN, GN, CODE) do { const int nitems = ((K_) / 64) * (((N_) + 31) / 32); int first = gw - (base % NGW); if (first < 0) first += NGW; \
        for (int it = first; it < nitems; it += NGW) transpose_item((SRC), (K_), (N_), (bf16_t*)(ws + (DST)), (GAIN), (GN), (CODE), scr, it, lane); base += nitems; } while (0)
    DO_MAT(ap->in[29], 1024, 2816, WS_WGU, ap->in[28], 1024, 2);
    DO_MAT(ap->in[30], 1024, 2816, WS_WGU, ap->in[28], 1024, 3);
    DO_MAT(ap->in[31], 2816, 1024, WS_WDOWN, nullptr, 0, 0);
    DO_MAT(ap->in[33], 1024, 1024, WS_WPLG, ap->in[32], 1024, 0);
    DO_MAT(ap->in[34], 256, 1024, WS_WPLP, nullptr, 0, 0);
#undef DO_MAT
}
__device__ __forceinline__ void phase0(LAS unsigned char* lds) {
    const CArgs ap = get_args();
    const int tid = get_tid(), lane = tid & 63, wave = tid >> 6;
    LAS float* scr = (LAS float*)(lds + wave * 16384);
    const int gw = blockIdx.x * 8 + wave, NGW = gridDim.x * 8;
    unsigned char* ws = ap->ws;
    int base = 0;
#define DO_MAT(SRC, K_, N_, DST, GAIN, GN, CODE) do { const int nitems = ((K_) / 64) * (((N_) + 31) / 32); int first = gw - (base % NGW); if (first < 0) first += NGW; \
        for (int it = first; it < nitems; it += NGW) transpose_item((SRC), (K_), (N_), (bf16_t*)(ws + (DST)), (GAIN), (GN), (CODE), scr, it, lane); base += nitems; } while (0)
    DO_MAT(ap->in[9], 1024, 5904, WS_WIN, nullptr, 0, 1);
    DO_MAT(ap->in[27], 2048, 1024, WS_WOUT, ap->in[15], 1024, 0);
    DO_MAT(ap->in[18], 64, 1024, WS_W2T, nullptr, 0, 0);
    DO_MAT(ap->in[20], 64, 1024, WS_A2T, nullptr, 0, 0);
    DO_MAT(ap->in[21], 128, 1024, WS_G2T, nullptr, 0, 0);
#undef DO_MAT
    bf16_t* xn = (bf16_t*)(ap->out + O_SSMS);
    const float* gmix = ap->in[8];
    f32x4 gv[4];
#pragma unroll
    for (int j = 0; j < 4; ++j) gv[j] = *(const f32x4*)(gmix + 4 * lane + 256 * j);
    for (int m = gw; m < NT; m += NGW) {
        const float* xr = (m < NT_P) ? ap->in[0] + (size_t)m * DM : ap->in[1] + (size_t)(m - NT_P) * DM;
        f32x4 v[4]; float s = 0.f;
#pragma unroll
        for (int j = 0; j < 4; ++j) { v[j] = *(const f32x4*)(xr + 4 * lane + 256 * j); s += pg8::sq4(v[j]); }
        const float rstd = rsqrtf(wave_sum(s) * (1.0f / DM) + 1e-6f);
#pragma unroll
        for (int j = 0; j < 4; ++j) { const f32x4 o = v[j] * rstd * gv[j]; u32x2 w; w.x = pk2(o[0], o[1]); w.y = pk2(o[2], o[3]); *(u32x2*)(xn + (size_t)m * DM + 4 * lane + 256 * j) = w; }
    }
    bf16_t* pb = (bf16_t*)(ws + WS_PB);
    for (int m = gw; m < NT; m += NGW) {
        const float* pr = (m < NT_P) ? ap->in[6] + (size_t)m * PLE : ap->in[7] + (size_t)(m - NT_P) * PLE;
        const f32x4 v = *(const f32x4*)(pr + 4 * lane); u32x2 w; w.x = pk2(v[0], v[1]); w.y = pk2(v[2], v[3]);
        *(u32x2*)(pb + (size_t)m * PLE + 4 * lane) = w;
    }
}
constexpr int US = 452;
__device__ __forceinline__ int rw_pcol(int cgp, int h) {
    return cgp < 8 ? COL_RW + h * 64 + 8 * cgp : cgp < 16 ? COL_RW + 1024 + h * 64 + 8 * (cgp - 8) : cgp < 24 ? COL_RW + 2048 + h * 64 + 8 * (cgp - 16) : COL_RW + 3072 + 8 * (cgp - 24);
}
__device__ __forceinline__ bool rw_item(int q, int tid, int& tok, int& cgp) {
    if (q == 0 && tid < 384) { tok = tid / 24; cgp = tid - tok * 24; return true; }
    return false;
}
__device__ __forceinline__ void phase_alo() {
    const CArgs ap = get_args();
    const int tid = get_tid();
    const bf16_t* __restrict__ P = (const bf16_t*)(ap->ws + WS_P);
    bf16_t* ALO = (bf16_t*)(ap->ws + WS_ALO);
    const float* __restrict__ mu = ap->in[16] + 3072; const float* __restrict__ sh = ap->in[5];
    for (int idx = blockIdx.x * 512 + tid; idx < NT * 32; idx += gridDim.x * 512) {
        const int row = idx >> 5, g = idx & 31, col = 8 * g;
        const u32x4 cw = *(const u32x4*)(P + (size_t)row * PP + COL_RW + 3072 + col);
        const int t = row < NT_P ? (row & 2047) : ((row - NT_P) & 7);
        float cur[8] = {bflo(cw.x), bfhi(cw.x), bflo(cw.y), bfhi(cw.y), bflo(cw.z), bfhi(cw.z), bflo(cw.w), bfhi(cw.w)}, prv[8];
        if (t > 0) { const u32x4 pw = *(const u32x4*)(P + (size_t)(row - 1) * PP + COL_RW + 3072 + col);
            prv[0] = bflo(pw.x); prv[1] = bfhi(pw.x); prv[2] = bflo(pw.y); prv[3] = bfhi(pw.y); prv[4] = bflo(pw.z); prv[5] = bfhi(pw.z); prv[6] = bflo(pw.w); prv[7] = bfhi(pw.w); }
        else if (row >= NT_P) { const float* sp = sh + (size_t)((row - NT_P) >> 3) * RWP + 3072 + col; const f32x4 s0a = *(const f32x4*)sp, s0b = *(const f32x4*)(sp + 4);
#pragma unroll
            for (int i = 0; i < 4; ++i) { prv[i] = s0a[i]; prv[4 + i] = s0b[i]; } }
        else {
#pragma unroll
            for (int i = 0; i < 8; ++i) prv[i] = 0.f; }
        const f32x4 m0 = *(const f32x4*)(mu + col), m1 = *(const f32x4*)(mu + col + 4);
        float o[8];
#pragma unroll
        for (int i = 0; i < 8; ++i) { const float m = i < 4 ? m0[i] : m1[i - 4]; float v = cur[i] + (prv[i] - cur[i]) * m;
            if (g < 8) v = tanh_fast(v); else if (g >= 16) v = sigm(v);
            o[i] = v; }
        u32x4 w; w.x = pk2(o[0], o[1]); w.y = pk2(o[2], o[3]); w.z = pk2(o[4], o[5]); w.w = pk2(o[6], o[7]);
        *(u32x4*)(ALO + (size_t)row * 256 + col) = w;
    }
}
template <bool PROMPT> __device__ __forceinline__ void rwkv_task(LAS unsigned char* lds, CArgs ap, int h, int row0, int L, const float* __restrict__ s0, const float* __restrict__ shift0, float* __restrict__ sout) {
    const bf16_t* __restrict__ P = (const bf16_t*)(ap->ws + WS_P);
    bf16_t* Y = (bf16_t*)ap->out;
    const float* __restrict__ mu = ap->in[16];
    LAS float* U = (LAS float*)lds;
    LAS float* Wd = U + 16 * US; LAS float* Aa = Wd + 1024; LAS float* Gg = Aa + 1024; LAS float* KK = Gg + 1024; LAS float* KKA = KK + 1024; LAS float* KP = KKA + 1024; LAS float* Oo = KP + 1024; LAS float* SB = Oo + 1024; LAS float* OoP = SB + 64;
    LAS _Float16* Wd16 = (LAS _Float16*)Wd; LAS _Float16* KK16 = (LAS _Float16*)KK; LAS _Float16* KKA16 = (LAS _Float16*)KKA; LAS _Float16* KP16 = (LAS _Float16*)KP; LAS _Float16* R16 = (LAS _Float16*)Oo;
    const int tid = get_tid(), lane = tid & 63, wave = tid >> 6;
    const int tokl = lane & 15, kq = 8 * (lane >> 4), ct = wave & 3;
    bf16x8 wf[4];
    {
        const int col = h * 64 + 16 * ct + tokl;
        if (wave < 4) {
            const bf16_t* w2t = (const bf16_t*)(ap->ws + WS_W2T) + (size_t)col * 64 + kq; const bf16_t* a2t = (const bf16_t*)(ap->ws + WS_A2T) + (size_t)col * 64 + kq;
            wf[0] = *(const bf16x8*)w2t; wf[1] = *(const bf16x8*)(w2t + 32); wf[2] = *(const bf16x8*)a2t; wf[3] = *(const bf16x8*)(a2t + 32);
        } else {
            const bf16_t* g2t = (const bf16_t*)(ap->ws + WS_G2T) + (size_t)col * 128 + kq;
#pragma unroll
            for (int s = 0; s < 4; ++s) wf[s] = *(const bf16x8*)(g2t + 32 * s);
        }
    }
    const int ecol = h * 64 + 16 * ct + 4 * (lane >> 4);
    const f32x4 w0v = *(const f32x4*)(ap->in[17] + ecol), a0v = *(const f32x4*)(ap->in[19] + ecol);
    const int etok = tid >> 5, c2 = 2 * (tid & 31), gc = h * 64 + c2;
    const float kkw0 = ap->in[22][gc], kkw1 = ap->in[22][gc + 1], ka0 = ap->in[23][gc], ka1 = ap->in[23][gc + 1], rk0 = ap->in[24][gc], rk1 = ap->in[24][gc + 1];
    const float lnw0 = ap->in[25][gc], lnw1 = ap->in[25][gc + 1], lnb0 = ap->in[26][gc], lnb1 = ap->in[26][gc + 1];
    const int rl = lane >> 3, kg = lane & 7, srow = wave * 8 + rl;
    h2v S2[4];
    if (s0 != nullptr) { const f32x4 x0 = *(const f32x4*)(s0 + srow * 64 + 8 * kg), x1 = *(const f32x4*)(s0 + srow * 64 + 8 * kg + 4);
        S2[0] = (h2v){(_Float16)x0[0], (_Float16)x0[1]}; S2[1] = (h2v){(_Float16)x0[2], (_Float16)x0[3]}; S2[2] = (h2v){(_Float16)x1[0], (_Float16)x1[1]}; S2[3] = (h2v){(_Float16)x1[2], (_Float16)x1[3]}; }
    else {
#pragma unroll
        for (int i = 0; i < 4; ++i) S2[i] = (h2v){(_Float16)0.f, (_Float16)0.f}; }
    const int nchunk = (L + 15) / 16;
    u32x4 rc[2], rp[2];
#define RW_LOAD(C) do { _Pragma("unroll") for (int q = 0; q < 2; ++q) { int tok, cgp; rc[q] = (u32x4){0u, 0u, 0u, 0u}; rp[q] = (u32x4){0u, 0u, 0u, 0u}; \
        if (rw_item(q, tid, tok, cgp)) { const int t = 16 * (C) + tok; const int pc = rw_pcol(cgp, h); \
            if (t < L) { rc[q] = *(const u32x4*)(P + (size_t)(row0 + t) * PP + pc); if (t > 0) rp[q] = *(const u32x4*)(P + (size_t)(row0 + t - 1) * PP + pc); } } } } while (0)
    f32x4 muv[2][2];
#pragma unroll
    for (int q = 0; q < 2; ++q) { int tok, cgp; muv[q][0] = (f32x4){0.f, 0.f, 0.f, 0.f}; muv[q][1] = muv[q][0];
        if (rw_item(q, tid, tok, cgp)) { const int mj = rw_pcol(cgp, h) - COL_RW; muv[q][0] = *(const f32x4*)(mu + mj); muv[q][1] = *(const f32x4*)(mu + mj + 4); } }
    const bf16_t* __restrict__ ALO = (const bf16_t*)(ap->ws + WS_ALO);
    bf16x8 af[4];
#define AF_LOAD(C) do { int r_ = row0 + 16 * (C) + tokl; r_ = r_ < NT ? r_ : NT - 1; const bf16_t* ar_ = ALO + (size_t)r_ * 256 + kq; \
        if (wave < 4) { af[0] = *(const bf16x8*)ar_; af[1] = *(const bf16x8*)(ar_ + 32); af[2] = *(const bf16x8*)(ar_ + 64); af[3] = *(const bf16x8*)(ar_ + 96); } \
        else { af[0] = *(const bf16x8*)(ar_ + 128); af[1] = *(const bf16x8*)(ar_ + 160); af[2] = *(const bf16x8*)(ar_ + 192); af[3] = *(const bf16x8*)(ar_ + 224); } } while (0)
    AF_LOAD(0);
    RW_LOAD(0);
    for (int c = 0; c < nchunk; ++c) {
#pragma unroll
        for (int q = 0; q < 2; ++q) { int tok, cgp;
            if (rw_item(q, tid, tok, cgp)) { const int t = 16 * c + tok; const int mj = rw_pcol(cgp, h) - COL_RW;
                float cur[8], prv[8];
                cur[0] = bflo(rc[q].x); cur[1] = bfhi(rc[q].x); cur[2] = bflo(rc[q].y); cur[3] = bfhi(rc[q].y); cur[4] = bflo(rc[q].z); cur[5] = bfhi(rc[q].z); cur[6] = bflo(rc[q].w); cur[7] = bfhi(rc[q].w);
                prv[0] = bflo(rp[q].x); prv[1] = bfhi(rp[q].x); prv[2] = bflo(rp[q].y); prv[3] = bfhi(rp[q].y); prv[4] = bflo(rp[q].z); prv[5] = bfhi(rp[q].z); prv[6] = bflo(rp[q].w); prv[7] = bfhi(rp[q].w);
                if (t == 0 && shift0 != nullptr) { const f32x4 s0a = *(const f32x4*)(shift0 + mj), s0b = *(const f32x4*)(shift0 + mj + 4);
#pragma unroll
                    for (int i = 0; i < 4; ++i) { prv[i] = s0a[i]; prv[4 + i] = s0b[i]; } }
                const f32x4 m0 = muv[q][0], m1 = muv[q][1];
                float o[8];
#pragma unroll
                for (int i = 0; i < 8; ++i) { const float m = i < 4 ? m0[i] : m1[i - 4]; float v = cur[i] + (prv[i] - cur[i]) * m;
                    if (q == 1) { if (tid < 128) v = tanh_fast(v); else v = sigm(v); }
                    o[i] = (PROMPT || t < L) ? v : 0.f; }
                *(LAS f32x4*)(U + tok * US + 8 * cgp) = (f32x4){o[0], o[1], o[2], o[3]}; *(LAS f32x4*)(U + tok * US + 8 * cgp + 4) = (f32x4){o[4], o[5], o[6], o[7]}; } }
        if (c + 1 < nchunk) RW_LOAD(c + 1);
        if (wave < 4) {
            f32x4 accw = {0.f, 0.f, 0.f, 0.f}, acca = {0.f, 0.f, 0.f, 0.f};
#pragma unroll
            for (int s = 0; s < 2; ++s) { accw = MFMA16(wf[s], af[s], accw); acca = MFMA16(wf[2 + s], af[2 + s], acca); }
            f32x4 dv, av;
#pragma unroll
            for (int j = 0; j < 4; ++j) { const float x = w0v[j] + accw[j]; dv[j] = __expf(-0.60653066f * sigm(x)); av[j] = sigm(a0v[j] + acca[j]); }
            *(LAS h2v*)(Wd16 + tokl * 64 + 16 * ct + 4 * (lane >> 4)) = (h2v){(_Float16)dv[0], (_Float16)dv[1]}; *(LAS h2v*)(Wd16 + tokl * 64 + 16 * ct + 4 * (lane >> 4) + 2) = (h2v){(_Float16)dv[2], (_Float16)dv[3]};
            *(LAS f32x4*)(Aa + tokl * 64 + 16 * ct + 4 * (lane >> 4)) = av;
        } else {
            f32x4 accg = {0.f, 0.f, 0.f, 0.f};
#pragma unroll
            for (int s = 0; s < 4; ++s) accg = MFMA16(wf[s], af[s], accg);
            *(LAS f32x4*)(Gg + tokl * 64 + 16 * ct + 4 * (lane >> 4)) = accg;
        }
        LBAR();
        if (c + 1 < nchunk) AF_LOAD(c + 1);
        {
            const float k0 = U[etok * US + 64 + c2], k1 = U[etok * US + 64 + c2 + 1], av0 = Aa[etok * 64 + c2], av1 = Aa[etok * 64 + c2 + 1];
            const float r0 = U[etok * US + c2], r1 = U[etok * US + c2 + 1];
            float q0 = k0 * kkw0, q1 = k1 * kkw1;
            const float ss = half_sum(q0 * q0 + q1 * q1);
            const float inv = fminf(rsqrtf(ss), 1e12f);
            q0 *= inv; q1 *= inv;
            const float kp0 = k0 * (1.0f + (av0 - 1.0f) * ka0), kp1 = k1 * (1.0f + (av1 - 1.0f) * ka1);
            *(LAS h2v*)(KK16 + etok * 64 + c2) = (h2v){(_Float16)q0, (_Float16)q1}; *(LAS h2v*)(KKA16 + etok * 64 + c2) = (h2v){(_Float16)(q0 * av0), (_Float16)(q1 * av1)};
            *(LAS h2v*)(KP16 + etok * 64 + c2) = (h2v){(_Float16)kp0, (_Float16)kp1}; *(LAS h2v*)(R16 + etok * 64 + c2) = (h2v){(_Float16)r0, (_Float16)r1};
            const float sb = half_sum(r0 * kp0 * rk0 + r1 * kp1 * rk1);
            if ((tid & 31) == 0) SB[etok] = sb;
        }
        LBAR();
        const int nv = PROMPT ? 16 : ((L - 16 * c) < 16 ? (L - 16 * c) : 16);
        u32x4 opA[5], opB[5]; float vA, vB;
#define RW_OPS(DST, VD, TOK) do { DST[0] = *(const LAS u32x4*)(Wd16 + (TOK) * 64 + 8 * kg); DST[1] = *(const LAS u32x4*)(KK16 + (TOK) * 64 + 8 * kg); \
            DST[2] = *(const LAS u32x4*)(KKA16 + (TOK) * 64 + 8 * kg); DST[3] = *(const LAS u32x4*)(KP16 + (TOK) * 64 + 8 * kg); \
            DST[4] = *(const LAS u32x4*)(R16 + (TOK) * 64 + 8 * kg); VD = U[(TOK) * US + 128 + srow]; } while (0)
#define H2(X, I) toh2((X)[I])
#define FD2(A, B, C) __builtin_amdgcn_fdot2(__builtin_bit_cast(fh2v, (A)), __builtin_bit_cast(fh2v, (B)), (C), false)
#define RW_STEP(SRC, VS, TOK) do { \
            float sk_ = FD2(S2[0], H2(SRC[1], 0), 0.f); sk_ = FD2(S2[1], H2(SRC[1], 1), sk_); sk_ = FD2(S2[2], H2(SRC[1], 2), sk_); sk_ = FD2(S2[3], H2(SRC[1], 3), sk_); \
            sk_ = red8(sk_); \
            const h2v nsk_ = __builtin_bit_cast(h2v, __builtin_amdgcn_cvt_pkrtz(-sk_, -sk_)), vv_ = __builtin_bit_cast(h2v, __builtin_amdgcn_cvt_pkrtz(VS, VS)); \
            _Pragma("unroll") for (int i = 0; i < 4; ++i) { h2v t_ = vv_ * H2(SRC[3], i); t_ = nsk_ * H2(SRC[2], i) + t_; S2[i] = S2[i] * H2(SRC[0], i) + t_; } \
            float q_ = FD2(S2[0], H2(SRC[4], 0), 0.f); q_ = FD2(S2[1], H2(SRC[4], 1), q_); q_ = FD2(S2[2], H2(SRC[4], 2), q_); q_ = FD2(S2[3], H2(SRC[4], 3), q_); \
            OoP[((TOK) * 64 + srow) * 8 + kg] = q_; } while (0)
        RW_OPS(opA, vA, 0);
#pragma unroll 1
        for (int tok = 0; tok < nv; tok += 2) {
            RW_OPS(opB, vB, tok + 1);
            RW_STEP(opA, vA, tok);
            RW_OPS(opA, vA, (tok + 2) & 15);
            RW_STEP(opB, vB, tok + 1);
        }
#undef RW_OPS
#undef RW_STEP
#undef H2
#undef FD2
        LBAR();
        {
            float o0, o1;
            { const LAS f32x4* op_ = (const LAS f32x4*)(OoP + (etok * 64 + c2) * 8); const f32x4 a0 = op_[0], a1 = op_[1], b0 = op_[2], b1 = op_[3];
              o0 = ((a0[0] + a0[1]) + (a0[2] + a0[3])) + ((a1[0] + a1[1]) + (a1[2] + a1[3])); o1 = ((b0[0] + b0[1]) + (b0[2] + b0[3])) + ((b1[0] + b1[1]) + (b1[2] + b1[3])); }
            const float mean = half_sum(o0 + o1) * (1.0f / 64.0f);
            const float d0 = o0 - mean, d1 = o1 - mean;
            const float var = half_sum(d0 * d0 + d1 * d1) * (1.0f / 64.0f);
            const float rs = rsqrtf(var + 64e-5f);
            const float sb = SB[etok], v0 = U[etok * US + 128 + c2], v1 = U[etok * US + 128 + c2 + 1];
            const float y0 = (d0 * rs * lnw0 + lnb0 + sb * v0) * Gg[etok * 64 + c2], y1 = (d1 * rs * lnw1 + lnb1 + sb * v1) * Gg[etok * 64 + c2 + 1];
            if (etok < nv) *(unsigned*)(Y + (size_t)(row0 + 16 * c + etok) * 2048 + 1024 + gc) = pk2(y0, y1);
        }
        LBAR();
    }
#undef RW_LOAD
#undef AF_LOAD
    *(f32x4*)(sout + srow * 64 + 8 * kg) = (f32x4){(float)S2[0].x, (float)S2[0].y, (float)S2[1].x, (float)S2[1].y}; *(f32x4*)(sout + srow * 64 + 8 * kg + 4) = (f32x4){(float)S2[2].x, (float)S2[2].y, (float)S2[3].x, (float)S2[3].y};
}
constexpr int S_CS = 0, S_BS = 17408, S_BT = 34816, S_XT = 53248, S_XW = 62464, S_SB = 71680, S_FL = 89088;
__device__ __forceinline__ void ssd_prompt_task(LAS unsigned char* lds, CArgs ap, int b, int h) {
    const bf16_t* __restrict__ P = (const bf16_t*)(ap->ws + WS_P);
    const float* __restrict__ dtraw = (const float*)(ap->ws + WS_DT);
    bf16_t* Y = (bf16_t*)ap->out;
    unsigned long long* ssqg = (unsigned long long*)(ap->ws + WS_SSQG);
    const int tid = get_tid(), lane = tid & 63, wave = tid >> 6, g = h >> 3;
    const int row0 = b * 2048;
    LAS float* acum = (LAS float*)(lds + S_FL); LAS float* dtv = acum + 64; LAS float* wgt = dtv + 64; LAS float* eac = wgt + 64; LAS float* misc = eac + 64;
    const float ah = -__expf(ap->in[13][h]), dtb = ap->in[12][h], Dh = ap->in[14][h];
    const int grp = tid % 80, run = tid / 80;
    int kind, pc, cc, loc;
    if (grp < 16) { kind = 0; loc = 4 * grp; pc = COL_XBC + h * 64 + loc; cc = h * 64 + loc; }
    else if (grp < 48) { kind = 1; loc = 4 * (grp - 16); pc = COL_XBC + 1024 + g * 128 + loc; cc = 1024 + g * 128 + loc; }
    else { kind = 2; loc = 4 * (grp - 48); pc = COL_XBC + 1280 + g * 128 + loc; cc = 1280 + g * 128 + loc; }
    f32x4 cw[4], cb;
    if (tid < 320) {
#pragma unroll
        for (int j = 0; j < 4; ++j) cw[j] = *(const f32x4*)(ap->in[10] + j * CONVD + cc);
        cb = *(const f32x4*)(ap->in[11] + cc);
    }
    const int tl = lane & 15, kq = 8 * (lane >> 4), q4 = 4 * (lane >> 4);
    const int qt = wave & 3, w2 = wave >> 2;
    f32x4 Sacc[4];
#pragma unroll
    for (int i = 0; i < 4; ++i) Sacc[i] = (f32x4){0.f, 0.f, 0.f, 0.f};
    for (int i = tid; i < 17408 / 4; i += 512) ((LAS unsigned*)(lds + S_SB))[i] = 0u;
    u32x2 raw[19];
#define RAWLD(CK) do { const int tb_ = 64 * (CK) + 16 * run - 3; _Pragma("unroll") for (int j = 0; j < 19; ++j) { const int t_ = tb_ + j; raw[j] = (u32x2){0u, 0u}; \
        if (t_ >= 0) raw[j] = *(const u32x2*)(P + (size_t)(row0 + t_) * PP + pc); } } while (0)
#define RAWF(J) ((f32x4){bflo(raw[J].x), bfhi(raw[J].x), bflo(raw[J].y), bfhi(raw[J].y)})
    if (tid < 320) RAWLD(0);
    for (int ck = 0; ck < 32; ++ck) {
        const int t0 = 64 * ck;
        if (tid < 320) {
            f32x4 r0, r1, r2;
            r0 = RAWF(0); r1 = RAWF(1); r2 = RAWF(2);
#pragma unroll
            for (int i = 0; i < 16; i += 2) {
                const f32x4 r3 = RAWF(3 + i), r4 = RAWF(4 + i);
                f32x4 oa = cb + cw[0] * r0 + cw[1] * r1 + cw[2] * r2 + cw[3] * r3;
                f32x4 ob = cb + cw[0] * r1 + cw[1] * r2 + cw[2] * r3 + cw[3] * r4;
#pragma unroll
                for (int j = 0; j < 4; ++j) { oa[j] = silu(oa[j]); ob[j] = silu(ob[j]); }
                const int tok = 16 * run + i;
                if (kind == 0) {
#pragma unroll
                    for (int j = 0; j < 4; ++j) *(LAS unsigned*)(lds + S_XT + (loc + j) * 144 + tok * 2) = pk2(oa[j], ob[j]);
                } else if (kind == 1) {
                    u32x2 wa, wb; wa.x = pk2(oa[0], oa[1]); wa.y = pk2(oa[2], oa[3]); wb.x = pk2(ob[0], ob[1]); wb.y = pk2(ob[2], ob[3]);
                    *(LAS u32x2*)(lds + S_BS + tok * 272 + loc * 2) = wa; *(LAS u32x2*)(lds + S_BS + (tok + 1) * 272 + loc * 2) = wb;
#pragma unroll
                    for (int j = 0; j < 4; ++j) *(LAS unsigned*)(lds + S_BT + (loc + j) * 144 + tok * 2) = pk2(oa[j], ob[j]);
                } else {
                    u32x2 wa, wb; wa.x = pk2(oa[0], oa[1]); wa.y = pk2(oa[2], oa[3]); wb.x = pk2(ob[0], ob[1]); wb.y = pk2(ob[2], ob[3]);
                    *(LAS u32x2*)(lds + S_CS + tok * 272 + loc * 2) = wa; *(LAS u32x2*)(lds + S_CS + (tok + 1) * 272 + loc * 2) = wb;
                }
                r0 = r2; r1 = r3; r2 = r4;
            }
            if (ck + 1 < 32) RAWLD(ck + 1);
        } else if (tid < 384) {
            const int tok = tid - 320;
            const float dt = softplus(dtraw[(size_t)(row0 + t0 + tok) * 16 + h] + dtb);
            float ac = dt * ah;
#pragma unroll
            for (int o = 1; o < 64; o <<= 1) { const float n = __shfl_up(ac, o); if (tok >= o) ac += n; }
            const float last = __shfl(ac, 63);
            acum[tok] = ac; dtv[tok] = dt; wgt[tok] = __expf(last - ac) * dt; eac[tok] = __expf(ac);
            if (tok == 0) misc[0] = __expf(last);
        }
        LBAR();
        { const int p = tid >> 3, s0 = (tid & 7) * 8; const u32x4 xv = *(const LAS u32x4*)(lds + S_XT + p * 144 + s0 * 2);
          const f32x4 wa = *(const LAS f32x4*)(wgt + s0), wb = *(const LAS f32x4*)(wgt + s0 + 4);
          u32x4 o; o.x = pk2(bflo(xv.x) * wa[0], bfhi(xv.x) * wa[1]); o.y = pk2(bflo(xv.y) * wa[2], bfhi(xv.y) * wa[3]); o.z = pk2(bflo(xv.z) * wb[0], bfhi(xv.z) * wb[1]); o.w = pk2(bflo(xv.w) * wb[2], bfhi(xv.w) * wb[3]);
          *(LAS u32x4*)(lds + S_XW + p * 144 + s0 * 2) = o; }
        u32x2 zpre[2];
#pragma unroll
        for (int i = 0; i < 2; ++i) zpre[i] = *(const u32x2*)(P + (size_t)(row0 + t0 + 16 * qt + tl) * PP + COL_Z + h * 64 + 16 * (2 * w2 + i) + q4);
        f32x4 G[2], Yc[2];
#pragma unroll
        for (int i = 0; i < 2; ++i) { G[i] = (f32x4){0.f, 0.f, 0.f, 0.f}; Yc[i] = (f32x4){0.f, 0.f, 0.f, 0.f}; }
#pragma unroll
        for (int ks = 0; ks < 4; ++ks) {
            const bf16x8 cf = ldfrag(lds + S_CS + (16 * qt + tl) * 272 + (32 * ks + kq) * 2);
#pragma unroll
            for (int i = 0; i < 2; ++i) {
                const int t2 = 2 * w2 + i;
                if (t2 <= qt) G[i] = MFMA16(ldfrag(lds + S_BS + (16 * t2 + tl) * 272 + (32 * ks + kq) * 2), cf, G[i]);
                Yc[i] = MFMA16(ldfrag(lds + S_SB + (16 * t2 + tl) * 272 + (32 * ks + kq) * 2), cf, Yc[i]);
            }
        }
        LBAR();
        {
            const int q = 16 * qt + tl; const float aq = acum[q], eq = eac[q];
#pragma unroll
            for (int i = 0; i < 2; ++i) { const int sb = 16 * (2 * w2 + i) + q4; float wv[4];
#pragma unroll
                for (int j = 0; j < 4; ++j) { const int s = sb + j; wv[j] = (s <= q) ? G[i][j] * __expf(aq - acum[s]) * dtv[s] : 0.f; }
                u32x2 o; o.x = pk2(wv[0], wv[1]); o.y = pk2(wv[2], wv[3]);
                *(LAS u32x2*)(lds + S_BS + q * 144 + sb * 2) = o;
                Yc[i] = Yc[i] * eq; }
        }
        LBAR();
        const float dec = misc[0];
#pragma unroll
        for (int i = 0; i < 4; ++i) Sacc[i] = Sacc[i] * dec;
#pragma unroll
        for (int ks = 0; ks < 2; ++ks) {
            const bf16x8 wfr = ldfrag(lds + S_BS + (16 * qt + tl) * 144 + (32 * ks + kq) * 2);
            const bf16x8 xwf = ldfrag(lds + S_XW + (16 * qt + tl) * 144 + (32 * ks + kq) * 2);
#pragma unroll
            for (int i = 0; i < 2; ++i) Yc[i] = MFMA16(ldfrag(lds + S_XT + (16 * (2 * w2 + i) + tl) * 144 + (32 * ks + kq) * 2), wfr, Yc[i]);
#pragma unroll
            for (int i = 0; i < 4; ++i) Sacc[i] = MFMA16(ldfrag(lds + S_BT + (16 * (4 * w2 + i) + tl) * 144 + (32 * ks + kq) * 2), xwf, Sacc[i]);
        }
        {
            const int q = 16 * qt + tl; const size_t grow = (size_t)(row0 + t0 + q);
            float ssl = 0.f;
#pragma unroll
            for (int i = 0; i < 2; ++i) { const int p0 = 16 * (2 * w2 + i) + q4;
                const u32x2 zw = zpre[i];
                const float z[4] = {bflo(zw.x), bfhi(zw.x), bflo(zw.y), bfhi(zw.y)}; float yv[4];
#pragma unroll
                for (int j = 0; j < 4; ++j) { const float xv = bf1(*(const LAS bf16_t*)(lds + S_XT + (p0 + j) * 144 + q * 2)); yv[j] = (Yc[i][j] + Dh * xv) * silu(z[j]); }
                u32x2 o; o.x = pk2(yv[0], yv[1]); o.y = pk2(yv[2], yv[3]);
                *(u32x2*)(Y + grow * 2048 + h * 64 + p0) = o;
                ssl += bflo(o.x) * bflo(o.x) + bfhi(o.x) * bfhi(o.x) + bflo(o.y) * bflo(o.y) + bfhi(o.y) * bfhi(o.y); }
            ssl += __shfl_xor(ssl, 16); ssl += __shfl_xor(ssl, 32);
            if (lane < 16) atomicAdd(ssqg + 2 * grow + g, (unsigned long long)(ssl * 1048576.0f));
        }
#pragma unroll
        for (int i = 0; i < 4; ++i) { u32x2 o; o.x = pk2(Sacc[i][0], Sacc[i][1]); o.y = pk2(Sacc[i][2], Sacc[i][3]);
            *(LAS u32x2*)(lds + S_SB + (16 * qt + tl) * 272 + (16 * (4 * w2 + i) + q4) * 2) = o; }
        LBAR();
    }
#undef RAWLD
#undef RAWF
    float* so = ap->out + O_SSMP + ((size_t)(b * 16 + h) * 64) * 128;
#pragma unroll
    for (int i = 0; i < 4; ++i) *(f32x4*)(so + (size_t)(16 * qt + tl) * 128 + 16 * (4 * w2 + i) + q4) = Sacc[i];
}
__device__ __forceinline__ void ssd_sample_task(LAS unsigned char* lds, CArgs ap, int b, int h) {
    const bf16_t* __restrict__ P = (const bf16_t*)(ap->ws + WS_P);
    const float* __restrict__ dtraw = (const float*)(ap->ws + WS_DT);
    bf16_t* Y = (bf16_t*)ap->out;
    unsigned long long* ssqg = (unsigned long long*)(ap->ws + WS_SSQG);
    const int tid = get_tid(), g = h >> 3, row0 = NT_P + 8 * b;
    LAS float* xs = (LAS float*)lds; LAS float* Bv = xs + 8 * 64; LAS float* Cv = Bv + 8 * 128; LAS float* dts = Cv + 8 * 128; LAS float* dAs = dts + 8;
    const float ah = -__expf(ap->in[13][h]), dtb = ap->in[12][h], Dh = ap->in[14][h];
    const int p = tid >> 3, ng = tid & 7, n0 = 16 * ng;
    f32x4 sv[4];
    { const float* sp = ap->in[2] + ((size_t)(b * 16 + h) * 64 + p) * 128 + n0;
#pragma unroll
      for (int i = 0; i < 4; ++i) sv[i] = *(const f32x4*)(sp + 4 * i); }
    float zv[8];
#pragma unroll
    for (int t = 0; t < 8; ++t) zv[t] = bf1(P[(size_t)(row0 + t) * PP + COL_Z + h * 64 + p]);
    if (tid < 320) {
        int pc, cc; LAS float* dst; int dstride;
        if (tid < 64) { pc = COL_XBC + h * 64 + tid; cc = h * 64 + tid; dst = xs + tid; dstride = 64; }
        else if (tid < 192) { const int n = tid - 64; pc = COL_XBC + 1024 + g * 128 + n; cc = 1024 + g * 128 + n; dst = Bv + n; dstride = 128; }
        else { const int n = tid - 192; pc = COL_XBC + 1280 + g * 128 + n; cc = 1280 + g * 128 + n; dst = Cv + n; dstride = 128; }
        const float* cwp = ap->in[10] + cc; const float w0 = cwp[0], w1 = cwp[CONVD], w2 = cwp[2 * CONVD], w3 = cwp[3 * CONVD], cb = ap->in[11][cc];
        const float* hs = ap->in[3] + (size_t)b * 3 * CONVD + cc;
        float r0 = hs[0], r1 = hs[CONVD], r2 = hs[2 * CONVD];
#pragma unroll
        for (int t = 0; t < 8; ++t) { const float r3 = bf1(P[(size_t)(row0 + t) * PP + pc]); dst[t * dstride] = silu(cb + w0 * r0 + w1 * r1 + w2 * r2 + w3 * r3); r0 = r1; r1 = r2; r2 = r3; }
    } else if (tid < 328) { const int t = tid - 320; const float dt = softplus(dtraw[(size_t)(row0 + t) * 16 + h] + dtb); dts[t] = dt; dAs[t] = __expf(dt * ah); }
    LBAR();
    float S[16];
#pragma unroll
    for (int i = 0; i < 4; ++i) { S[4 * i] = sv[i][0]; S[4 * i + 1] = sv[i][1]; S[4 * i + 2] = sv[i][2]; S[4 * i + 3] = sv[i][3]; }
#pragma unroll
    for (int t = 0; t < 8; ++t) {
        const float dA = dAs[t], xv = xs[t * 64 + p], xdt = xv * dts[t]; float y = 0.f;
#pragma unroll
        for (int i = 0; i < 4; ++i) { const f32x4 bv = *(const LAS f32x4*)(Bv + t * 128 + n0 + 4 * i), cv = *(const LAS f32x4*)(Cv + t * 128 + n0 + 4 * i);
#pragma unroll
            for (int j = 0; j < 4; ++j) { S[4 * i + j] = S[4 * i + j] * dA + xdt * bv[j]; y += S[4 * i + j] * cv[j]; } }
        y = red8(y);
        float ysq = 0.f;
        if (ng == 0) { const float yv = (y + Dh * xv) * silu(zv[t]);
            const bf16_t yb = (bf16_t)(pk2(yv, 0.f) & 0xffffu); Y[(size_t)(row0 + t) * 2048 + h * 64 + p] = yb; ysq = bf1(yb) * bf1(yb); }
        ysq += dppf<0x128>(ysq);
        ysq += __shfl_xor(ysq, 16); ysq += __shfl_xor(ysq, 32);
        if ((tid & 63) == 0) atomicAdd(ssqg + 2 * (size_t)(row0 + t) + g, (unsigned long long)(ysq * 1048576.0f));
    }
    float* so = ap->out + O_SSMS + ((size_t)(b * 16 + h) * 64 + p) * 128 + n0;
#pragma unroll
    for (int i = 0; i < 4; ++i) *(f32x4*)(so + 4 * i) = (f32x4){S[4 * i], S[4 * i + 1], S[4 * i + 2], S[4 * i + 3]};
    LBAR();
}
__device__ __forceinline__ void copy_states(CArgs ap, int part, int nparts) {
    const int tid = get_tid();
    const bf16_t* __restrict__ P = (const bf16_t*)(ap->ws + WS_P);
    float* out = ap->out;
    constexpr int PER = 3 * CONVD + RWP;
    for (int idx = part * 512 + tid; idx < 136 * PER; idx += nparts * 512) {
        const int s = idx / PER, e = idx - s * PER;
        const int last = s < 8 ? s * 2048 + 2047 : NT_P + 8 * (s - 8) + 7;
        if (e < 3 * CONVD) { const int j = e / CONVD, c = e - j * CONVD; const float v = bf1(P[(size_t)(last - 2 + j) * PP + COL_XBC + c]);
            if (s < 8) out[O_CONVP + (size_t)s * 3 * CONVD + e] = v; else out[O_CONVS + (size_t)(s - 8) * 3 * CONVD + e] = v; }
        else { const int c = e - 3 * CONVD; const float v = bf1(P[(size_t)last * PP + COL_RW + c]);
            if (s < 8) out[O_SHIFTP + (size_t)s * RWP + c] = v; else out[O_SHIFTS + (size_t)(s - 8) * RWP + c] = v; }
    }
}
__device__ __forceinline__ void mixer_task(LAS unsigned char* lds, CArgs ap, int task) {
    if (task < 128) { const int b = task >> 4, h = task & 15; rwkv_task<true>(lds, ap, h, b * 2048, 2048, nullptr, nullptr, ap->out + O_WKVP + (size_t)(b * 16 + h) * 4096); }
    else if (task < 256) { const int s = task - 128; ssd_prompt_task(lds, ap, s >> 4, s & 15); }
    else if (task < 256 + 2048) { const int s = task - 256; ssd_sample_task(lds, ap, s >> 4, s & 15); }
    else { const int s = task - 2304, b = s >> 4, h = s & 15;
        rwkv_task<false>(lds, ap, h, NT_P + 8 * b, 8, ap->in[4] + (size_t)(b * 16 + h) * 4096, ap->in[5] + (size_t)b * RWP, ap->out + O_WKVS + (size_t)(b * 16 + h) * 4096); }
}
__device__ __forceinline__ void phase_mixers(LAS unsigned char* lds) {
    const CArgs ap = get_args();
    const int nb = gridDim.x, bid = blockIdx.x;
    if (nb == 256) {
        constexpr int NRS = 0;
        mixer_task(lds, ap, bid);
        if (bid >= 128) { for (int s = bid - 128; s < 4096 - 128 * NRS; s += 128) mixer_task(lds, ap, 256 + s); copy_states(ap, bid - 128, 128); }
        else { for (int k = 0; k < NRS; ++k) mixer_task(lds, ap, 256 + 4096 - 128 * NRS + 128 * k + bid); }
    } else {
        for (int task = bid; task < 4352; task += nb) mixer_task(lds, ap, task);
        copy_states(ap, bid, nb);
    }
}
__device__ __forceinline__ void phase_final() {
    const CArgs ap = get_args();
    const int tid = get_tid(), lane = tid & 63, wave = tid >> 6;
    const int gw = blockIdx.x * 8 + wave, NGW = gridDim.x * 8;
    const float* __restrict__ hbuf = (const float*)(ap->ws + WS_H); const unsigned long long* ssq3 = (const unsigned long long*)(ap->ws + WS_SSQ3); const float* gf = ap->in[35];
    f32x4 gv[4];
#pragma unroll
    for (int j = 0; j < 4; ++j) gv[j] = *(const f32x4*)(gf + 4 * lane + 256 * j);
    for (int m = gw; m < NT; m += NGW) {
        const float rstd = rsqrtf((float)ssq3[m] * (1.0f / (1024.0f * 1048576.0f)) + 1e-6f);
#pragma unroll
        for (int j = 0; j < 4; ++j) { const f32x4 v = *(const f32x4*)(hbuf + (size_t)m * DM + 4 * lane + 256 * j); *(f32x4*)(ap->out + (size_t)m * DM + 4 * lane + 256 * j) = v * rstd * gv[j]; }
    }
}
#define XB_TMO      128
#define XB_XCNT(j)  (256  + 64 * (j))
#define XB_XSUB(j)  (1280 + 64 * (j))
#define XB_XGEN(j)  (2304 + 64 * (j))
#define XB_TOP      3328
#define XB_TOPGEN   3392
#define XCD_BAR_WORDS 3456
#define XB_SPIN_CAP (1u << 18)

__device__ __forceinline__ unsigned xb_ld(unsigned* p)              { return __hip_atomic_load(p, __ATOMIC_RELAXED, __HIP_MEMORY_SCOPE_AGENT); }
__device__ __forceinline__ unsigned xb_add(unsigned* p, unsigned v) { return __hip_atomic_fetch_add(p, v, __ATOMIC_RELAXED, __HIP_MEMORY_SCOPE_AGENT); }
__device__ __forceinline__ unsigned xb_xcc_id() { return (unsigned)__builtin_amdgcn_s_getreg((3 << 11) | 20) & 0xFu; }
#define XB_SPIN(cond, bar) do { unsigned _sp = 0; while (cond) { __builtin_amdgcn_s_sleep(1); \
    if ((++_sp & 255u) == 0u) { if (xb_ld(&(bar)[XB_TMO])) break; if (_sp > XB_SPIN_CAP) { atomicAdd(&(bar)[XB_TMO], 1u); break; } } } } while (0)

struct XcdBarrier {
    unsigned* bar; unsigned x;
    volatile LAS unsigned* st;
};

__device__ __forceinline__ XcdBarrier xcd_barrier_post(unsigned* bar, volatile LAS unsigned* st) {
    XcdBarrier b; b.bar = bar; b.x = xb_xcc_id(); b.st = st;
    if (threadIdx.x == 0) (void)xb_add(&bar[XB_XCNT(b.x)], 1u);
    return b;
}
__device__ __forceinline__ void xcd_barrier_complete(unsigned* bar, unsigned x, unsigned& nloc, unsigned& nx) {
    const unsigned G = gridDim.x * gridDim.y * gridDim.z;
    unsigned sum, cnt, mine, sp = 0u;
    for (;;) {
        sum = 0u; cnt = 0u; mine = 0u;
#pragma unroll
        for (unsigned j = 0; j < 16; ++j) { const unsigned c = xb_ld(&bar[XB_XCNT(j)]); sum += c; cnt += (c > 0u) ? 1u : 0u; mine = (j == x) ? c : mine; }
        if (sum == G) break;
        __builtin_amdgcn_s_sleep(1);
        if ((++sp & 255u) == 0u) { if (xb_ld(&bar[XB_TMO])) break; if (sp > XB_SPIN_CAP) { atomicAdd(&bar[XB_TMO], 1u); break; } }
    }
    nloc = mine > 0u ? mine : 1u; nx = cnt > 0u ? cnt : 1u;
}

__device__ __forceinline__ void xcd_barrier(const XcdBarrier& b) {
    asm volatile("s_waitcnt vmcnt(0)" ::: "memory");
    __syncthreads();
    if (threadIdx.x == 0) {
        unsigned* bar = b.bar;
        __builtin_amdgcn_s_waitcnt(0);
        unsigned nloc = b.st[0], nx = b.st[1];
        if (nloc == 0u) { xcd_barrier_complete(bar, b.x, nloc, nx); b.st[0] = nloc; b.st[1] = nx; }
        const unsigned old = xb_add(&bar[XB_XSUB(b.x)], 1u);
        const unsigned gen = old / nloc;
        if (old + 1u == (gen + 1u) * nloc) {
            __builtin_amdgcn_fence(__ATOMIC_RELEASE, "agent");
            asm volatile("s_waitcnt vmcnt(0)" ::: "memory");
            const unsigned og = xb_add(&bar[XB_TOP], 1u);
            const unsigned tg = og / nx;
            if (og + 1u == (tg + 1u) * nx) xb_add(&bar[XB_TOPGEN], 1u);
            else XB_SPIN(xb_ld(&bar[XB_TOPGEN]) == tg, bar);
            __builtin_amdgcn_fence(__ATOMIC_ACQUIRE, "agent");
            xb_add(&bar[XB_XGEN(b.x)], 1u);
            asm volatile("s_waitcnt vmcnt(0)" ::: "memory");
        } else {
            XB_SPIN(xb_ld(&bar[XB_XGEN(b.x)]) == gen, bar);
            __builtin_amdgcn_fence(__ATOMIC_ACQUIRE, "agent");
            asm volatile("s_waitcnt vmcnt(0)" ::: "memory");
        }
    }
    __syncthreads();
}


__device__ __forceinline__ void gsync(cg::grid_group& grid) {
    asm volatile("s_waitcnt vmcnt(0) lgkmcnt(0)" ::: "memory");
    grid.sync();
    __builtin_amdgcn_fence(__ATOMIC_ACQUIRE, "agent");
    asm volatile("s_waitcnt vmcnt(0)" ::: "memory");
}
__global__ void __launch_bounds__(512, 2) mega_fwd(Args a_unused) {
    extern __shared__ __attribute__((aligned(16))) unsigned char lds_raw[];
    LAS unsigned char* lds = (LAS unsigned char*)lds_raw;
    cg::grid_group grid = cg::this_grid();
    const int G = gridDim.x, bid = blockIdx.x;
    volatile LAS unsigned* xst = (volatile LAS unsigned*)(lds + 131072 + 64);
    if (threadIdx.x < 2) xst[threadIdx.x] = 0u;
    __syncthreads();
    XcdBarrier xbar = xcd_barrier_post((unsigned*)(get_args()->ws + WS_BAR), xst);
    phase0(lds);
    if (get_args()->ws == nullptr) gsync(grid);
    xcd_barrier(xbar);
    { const CArgs ap = get_args(); unsigned char* ws = ap->ws;
      pg8::Gemm g{(const bf16_t*)(ap->out + O_SSMS), (const bf16_t*)(ws + WS_WIN), NT, NW_IN, 1024}; pg8::StaticOrder S; S.init(NT, NW_IN, G, bid);
      pg8::EpiPlain E{(bf16_t*)(ws + WS_P), PP, 23, (float*)(ws + WS_DT)};
      pg8::gemm_phase<pg8::EpiPlain, pg8::StaticOrder, true, true>(lds, g, S, E); }
    xcd_barrier(xbar);
    phase_alo();
    xcd_barrier(xbar);
    phase_mixers(lds);
    xcd_barrier(xbar);
    { const CArgs ap = get_args(); unsigned char* ws = ap->ws;
      pg8::Gemm g{(const bf16_t*)ap->out, (const bf16_t*)(ws + WS_WOUT), NT, 1024, 2048}; pg8::StaticOrder S; S.init(NT, 1024, G, bid);
      pg8::EpiRes<true> E{(const unsigned long long*)(ws + WS_SSQG), ap->in[0], ap->in[1], (float*)(ws + WS_H), (bf16_t*)(ws + WS_HB), (unsigned long long*)(ws + WS_SSQ1)};
      pg8::gemm_phase<pg8::EpiRes<true>, pg8::StaticOrder, true, true>(lds, g, S, E); }
    { const int rem = ((NT / 256) * 4) % G; phase0b(lds, (G >= 64 && rem > 0 && rem < G - 32) ? rem : 0); }
    xcd_barrier(xbar);
    { const CArgs ap = get_args(); unsigned char* ws = ap->ws;
      pg8::Gemm g{(const bf16_t*)(ws + WS_HB), (const bf16_t*)(ws + WS_WGU), NT, 2 * DFF, 1024}; pg8::StaticOrder S; S.init(NT, 2 * DFF, G, bid);
      pg8::EpiGU E{(bf16_t*)(ws + WS_FF), (const unsigned long long*)(ws + WS_SSQ1)};
      pg8::gemm_phase<pg8::EpiGU, pg8::StaticOrder, true, true>(lds, g, S, E); }
    xcd_barrier(xbar);
    { const CArgs ap = get_args(); unsigned char* ws = ap->ws; float* hbuf = (float*)(ws + WS_H);
      pg8::Gemm g{(const bf16_t*)(ws + WS_FF), (const bf16_t*)(ws + WS_WDOWN), NT, 1024, DFF}; pg8::StaticOrder S; S.init(NT, 1024, G, bid);
      pg8::EpiRes<false> E{nullptr, hbuf, hbuf + (size_t)NT_P * 1024, hbuf, (bf16_t*)(ws + WS_HB), (unsigned long long*)(ws + WS_SSQ2)};
      pg8::gemm_phase<pg8::EpiRes<false>, pg8::StaticOrder, true, true>(lds, g, S, E); }
    { const int rem_ = ((NT / 256) * 4) % G; const int ppf = (G >= 64 && rem_ > 0 && rem_ < G - 32) ? rem_ : 0;
      if (bid >= ppf) { const CArgs ap = get_args(); unsigned char* ws = ap->ws;
      pg8::Gemm g{(const bf16_t*)(ws + WS_PB), (const bf16_t*)(ws + WS_WPLP), NT, 1024, 256}; pg8::StaticOrder S; S.init(NT, 1024, G - ppf, bid - ppf);
      pg8::EpiPlain E{(bf16_t*)ap->out, 1024, 4, nullptr};
      pg8::gemm_phase<pg8::EpiPlain, pg8::StaticOrder, true, true>(lds, g, S, E); } }
    xcd_barrier(xbar);
    { const CArgs ap = get_args(); unsigned char* ws = ap->ws;
      pg8::Gemm g{(const bf16_t*)(ws + WS_HB), (const bf16_t*)(ws + WS_WPLG), NT, 1024, 1024}; pg8::StaticOrder S; S.init(NT, 1024, G, bid);
      pg8::EpiPle E{(float*)(ws + WS_H), (const bf16_t*)ap->out, (const unsigned long long*)(ws + WS_SSQ2), (unsigned long long*)(ws + WS_SSQ3)};
      pg8::gemm_phase<pg8::EpiPle, pg8::StaticOrder, true, true>(lds, g, S, E); }
    xcd_barrier(xbar);
    phase_final();
}

extern "C" void kernel_launch(void* const* d_in, const int* in_sizes, int n_in, void* d_out, int out_size, void* d_ws, size_t ws_size, hipStream_t stream) {
    static int grid_blocks = 0;
    if (grid_blocks == 0) {
        if (n_in != 36 || out_size != (int)O_END || ws_size < 256 * MiB) { fprintf(stderr, "kernel_launch: unexpected problem shape (n_in %d out %d ws %zu)\n", n_in, out_size, ws_size); grid_blocks = -1; return; }
        int dev = 0, cus = 0, per_cu = 0;
        hipGetDevice(&dev);
        hipDeviceGetAttribute(&cus, hipDeviceAttributeMultiprocessorCount, dev);
        if (hipFuncSetAttribute((const void*)mega_fwd, hipFuncAttributeMaxDynamicSharedMemorySize, LDS_BYTES) != hipSuccess) { fprintf(stderr, "kernel_launch: hipFuncSetAttribute failed\n"); grid_blocks = -1; return; }
        if (hipOccupancyMaxActiveBlocksPerMultiprocessor(&per_cu, (const void*)mega_fwd, 512, LDS_BYTES) != hipSuccess || per_cu < 1) per_cu = 1;
        (void)hipGetLastError();
        grid_blocks = cus * per_cu;
    }
    if (grid_blocks < 0) return;
    hipMemsetAsync(d_ws, 0, WS_ZERO_BYTES, stream);
    Args a{};
    for (int i = 0; i < 36; ++i) a.in[i] = (const float*)d_in[i];
    a.out = (float*)d_out; a.ws = (unsigned char*)d_ws;
    void* args[] = {&a};
    hipError_t e = hipLaunchCooperativeKernel((const void*)mega_fwd, dim3(grid_blocks), dim3(512), args, LDS_BYTES, stream);
    if (e != hipSuccess) fprintf(stderr, "cooperative launch failed: %s (grid %d)\n", hipGetErrorString(e), grid_blocks);
}
```

```cpp
#include <hip/hip_runtime.h>
#include <hip/hip_cooperative_groups.h>
#include <cstdio>
#include <cstdint>
namespace cg = cooperative_groups;
namespace pg8 {
#define PG8_LAS __attribute__((address_space(3)))
typedef unsigned short bf16_t;
typedef short bf16x8 __attribute__((ext_vector_type(8)));
typedef float f32x4 __attribute__((ext_vector_type(4)));
typedef unsigned u32x4 __attribute__((ext_vector_type(4)));
constexpr int BM = 256, BK = 64, HALF = 128, HTB = HALF * BK * 2  , STAGE_BYTES = 8 * HTB, NXCD = 8, WGM = 8;

__host__ __device__ __forceinline__ int lds_byte(int r, int c) { const int st = (r >> 4) * 2 + (c >> 5), rr = r & 15, cc = c & 31, ob = rr * 64 + cc * 2; return st * 1024 + (ob ^ (((ob >> 9) & 1) << 5)); }
__host__ __device__ __forceinline__ void stage_rc(int b, int& R, int& C) { const int st = b / 1024, sb = b % 1024, swz = sb ^ (((sb >> 9) & 1) << 5); R = (st >> 1) * 16 + swz / 64; C = (st & 1) * 32 + (swz % 64) / 2; }
__host__ __device__ __forceinline__ int perm32(int rho) { const int n = rho >> 4, i = rho & 15; return 8 * (i >> 2) + 4 * n + (i & 3); }

struct Unit { int pm, pn; };
struct Gemm { const bf16_t* A; const bf16_t* Bt; int M, N, K; };

struct StaticOrder {
    int nM, nN, nwg, G, c;
    __host__ __device__ void init(int M, int N, int G_, int c_) { nM = M / BM; nN = N / BM; nwg = nM * nN; G = G_; c = c_; }
    __host__ __device__ bool next(int i, Unit& u) const {
        const long L = (long)i * G + c; if (L >= nwg) return false;
        int wgid = (int)L; { const int q = nwg / NXCD, r = nwg % NXCD, xcd = wgid % NXCD, off = wgid / NXCD; wgid = (xcd < r ? xcd * (q + 1) : r * (q + 1) + (xcd - r) * q) + off; }
        const int nig = WGM * nN, gid = wgid / nig, fm = gid * WGM, gsz = (nM - fm) < WGM ? (nM - fm) : WGM;
        u.pm = fm + ((wgid % nig) % gsz); u.pn = (wgid % nig) / gsz; return true;
    }
    __device__ __forceinline__ void a_ready(const Unit&) const {}
    __device__ __forceinline__ void done(const Unit&) const {}
};


template <class Epi, class Sched, bool ALIGN_EPI = false, bool SP2 = false>
__device__ __forceinline__ void gemm_phase(PG8_LAS unsigned char* lds, const Gemm g, const Sched& S, const Epi& E) {
    int tid_ = threadIdx.x; asm volatile("" : "+v"(tid_));
    const int tid = tid_, wid = __builtin_amdgcn_readfirstlane(tid >> 6), lane = tid & 63, wr = wid >> 2, wc = wid & 3, fr = lane & 15, fq = lane >> 4;
    const int K = g.K, nt = K / BK;
    unsigned voffA[2], voffB[2];
#pragma unroll
    for (int i = 0; i < 2; ++i) { int R, C; stage_rc(tid * 16 + i * 8192, R, C); const int Rb = Epi::PERM ? ((R & ~31) + perm32(R & 31)) : R;
        voffA[i] = (unsigned)(R * K + C) * 2u; voffB[i] = (unsigned)(Rb * K + C) * 2u; }
    const size_t kstep = (size_t)(BK * 2);
    const size_t hstep = (size_t)HALF * K * 2;
    const size_t tstep = 2 * hstep;
    const unsigned ldsw = (unsigned)wid * 1024u;
    const int aoff = lds_byte(wr * 64 + fr, fq * 8), boff = lds_byte(wc * 32 + fr, fq * 8);
#define PG8_SA(b, h) (((b) * 2 + (h)) * HTB)
#define PG8_SB(b, h) ((4 + (b) * 2 + (h)) * HTB)
#define PG8_STAGE(bufoff, gbase, voff) do { _Pragma("unroll") for (int _i = 0; _i < 2; ++_i) \
        __builtin_amdgcn_global_load_lds((const unsigned*)((const char*)(gbase) + (voff)[_i]), (PG8_LAS unsigned*)(lds + (bufoff) + ldsw + _i * 8192), 16, 0, 0); } while (0)
#define PG8_LDA(dst, b, h) do { _Pragma("unroll") for (int m = 0; m < 4; ++m) _Pragma("unroll") for (int k = 0; k < 2; ++k) dst[m][k] = *(const PG8_LAS bf16x8*)(lds + PG8_SA(b, h) + aoff + m * 2048 + k * 1024); } while (0)
#define PG8_LDB(dst, b, h) do { _Pragma("unroll") for (int n = 0; n < 2; ++n) _Pragma("unroll") for (int k = 0; k < 2; ++k) dst[n][k] = *(const PG8_LAS bf16x8*)(lds + PG8_SB(b, h) + boff + n * 2048 + k * 1024); } while (0)
#define PG8_MMA(ai, bj, At, Bt) do { __builtin_amdgcn_s_setprio(1); _Pragma("unroll") for (int m = 0; m < 4; ++m) _Pragma("unroll") for (int n = 0; n < 2; ++n) _Pragma("unroll") for (int k = 0; k < 2; ++k) \
        acc[ai][bj][m][n] = __builtin_amdgcn_mfma_f32_16x16x32_bf16(Bt[n][k], At[m][k], acc[ai][bj][m][n], 0, 0, 0); __builtin_amdgcn_s_setprio(0); } while (0)
#define PG8_WAIT_V(n) asm volatile("s_waitcnt vmcnt(" #n ")" ::: "memory")
#define PG8_WAIT_L(n) asm volatile("s_waitcnt lgkmcnt(" #n ")" ::: "memory")
#define PG8_BAR __builtin_amdgcn_s_barrier()
#define PG8_SCHED __builtin_amdgcn_sched_barrier(0)
    Unit cur, nxt; int ui = 0;
    if (!S.next(0, cur)) return;
    f32x4 acc[2][2][4][2];
#pragma unroll
    for (int a = 0; a < 2; ++a)
#pragma unroll
        for (int b = 0; b < 2; ++b)
#pragma unroll
            for (int m = 0; m < 4; ++m)
#pragma unroll
                for (int n = 0; n < 2; ++n) acc[a][b][m][n] = (f32x4){0.f, 0.f, 0.f, 0.f};
    bf16x8 At[4][2], B0[2][2], B1[2][2];
    const char* cA = (const char*)g.A + (size_t)cur.pm * tstep; const char* cB = (const char*)g.Bt + (size_t)cur.pn * tstep;
    S.a_ready(cur);
    if constexpr (SP2) {
        PG8_STAGE(PG8_SB(0, 0), cB, voffB); PG8_STAGE(PG8_SB(0, 1), cB + hstep, voffB); PG8_STAGE(PG8_SA(0, 0), cA, voffA); PG8_STAGE(PG8_SA(0, 1), cA + hstep, voffA);
        if (wr == 1) PG8_BAR;
        PG8_WAIT_V(2); PG8_BAR;
        PG8_STAGE(PG8_SB(1, 0), cB + kstep, voffB); PG8_STAGE(PG8_SA(1, 0), cA + kstep, voffA); PG8_STAGE(PG8_SB(1, 1), cB + hstep + kstep, voffB);
        PG8_WAIT_V(6); PG8_BAR;
    } else {
        PG8_STAGE(PG8_SB(0, 0), cB, voffB); PG8_STAGE(PG8_SA(0, 0), cA, voffA); PG8_STAGE(PG8_SB(0, 1), cB + hstep, voffB); PG8_STAGE(PG8_SA(0, 1), cA + hstep, voffA);
        if (wr == 1) PG8_BAR;
        PG8_WAIT_V(4); PG8_BAR;
        PG8_STAGE(PG8_SB(1, 0), cB + kstep, voffB); PG8_STAGE(PG8_SA(1, 0), cA + kstep, voffA); PG8_STAGE(PG8_SB(1, 1), cB + hstep + kstep, voffB);
        PG8_WAIT_V(6); PG8_BAR;
    }
    for (;;) {
        const bool has_next = S.next(ui + 1, nxt);
        const char* nA = has_next ? (const char*)g.A + (size_t)nxt.pm * tstep : cA; const char* nB = has_next ? (const char*)g.Bt + (size_t)nxt.pn * tstep : cB;
        for (int t = 0; t < nt; t += 2) {
            const bool last = (t == nt - 2);
            const char* a1 = cA + (size_t)(t + 1) * kstep;
            const char* a2 = last ? nA : cA + (size_t)(t + 2) * kstep; const char* b2 = last ? nB : cB + (size_t)(t + 2) * kstep;
            const char* a3 = a2 + kstep; const char* b3 = b2 + kstep;
            if (last && has_next) S.a_ready(nxt);
            if constexpr (SP2) {
            PG8_LDB(B0, 0, 0); PG8_LDB(B1, 0, 1); PG8_SCHED; PG8_LDA(At, 0, 0); PG8_STAGE(PG8_SA(1, 1), a1 + hstep, voffA);
            PG8_WAIT_V(8); PG8_WAIT_L(0); PG8_BAR; PG8_MMA(0, 0, At, B0); PG8_MMA(0, 1, At, B1); PG8_BAR; PG8_SCHED;
            PG8_LDA(At, 0, 1); PG8_STAGE(PG8_SB(0, 0), b2, voffB); PG8_STAGE(PG8_SB(0, 1), b2 + hstep, voffB); PG8_STAGE(PG8_SA(0, 0), a2, voffA);
            PG8_WAIT_V(8); PG8_WAIT_L(0); PG8_BAR; PG8_MMA(1, 0, At, B0); PG8_MMA(1, 1, At, B1); PG8_BAR; PG8_SCHED;
            PG8_LDB(B0, 1, 0); PG8_LDB(B1, 1, 1); PG8_SCHED; PG8_LDA(At, 1, 0); PG8_STAGE(PG8_SA(0, 1), a2 + hstep, voffA);
            PG8_WAIT_V(8); PG8_WAIT_L(0); PG8_BAR; PG8_MMA(0, 0, At, B0); PG8_MMA(0, 1, At, B1); PG8_BAR; PG8_SCHED;
            PG8_LDA(At, 1, 1); PG8_STAGE(PG8_SB(1, 0), b3, voffB); PG8_STAGE(PG8_SB(1, 1), b3 + hstep, voffB); PG8_STAGE(PG8_SA(1, 0), a3, voffA);
            PG8_WAIT_V(8); PG8_WAIT_L(0); PG8_BAR; PG8_MMA(1, 0, At, B0); PG8_MMA(1, 1, At, B1); PG8_BAR; PG8_SCHED;
            if constexpr (Epi::KSCALE) { const int kd = (t + 2) * BK; if (kd == 512 || kd == 1024) E.kscale(acc, cur, kd, wr, fr); }
            } else {
            PG8_LDB(B0, 0, 0); PG8_SCHED; PG8_LDA(At, 0, 0); PG8_STAGE(PG8_SA(1, 1), a1 + hstep, voffA);
            PG8_WAIT_L(8); PG8_BAR; PG8_WAIT_L(0); PG8_MMA(0, 0, At, B0); PG8_BAR; PG8_SCHED;
            PG8_LDB(B1, 0, 1); PG8_STAGE(PG8_SB(0, 0), b2, voffB);
            PG8_BAR; PG8_WAIT_L(0); PG8_MMA(0, 1, At, B1); PG8_BAR;
            PG8_LDA(At, 0, 1); PG8_STAGE(PG8_SA(0, 0), a2, voffA);
            PG8_BAR; PG8_WAIT_L(0); PG8_MMA(1, 0, At, B0); PG8_BAR; PG8_SCHED;
            PG8_STAGE(PG8_SB(0, 1), b2 + hstep, voffB);
            PG8_WAIT_V(6); PG8_BAR; PG8_MMA(1, 1, At, B1); PG8_BAR;
            PG8_LDB(B0, 1, 0); PG8_SCHED; PG8_LDA(At, 1, 0); PG8_STAGE(PG8_SA(0, 1), a2 + hstep, voffA);
            PG8_WAIT_L(8); PG8_BAR; PG8_WAIT_L(0); PG8_MMA(0, 0, At, B0); PG8_BAR; PG8_SCHED;
            PG8_LDB(B1, 1, 1); PG8_STAGE(PG8_SB(1, 0), b3, voffB);
            PG8_BAR; PG8_WAIT_L(0); PG8_MMA(0, 1, At, B1); PG8_BAR;
            PG8_LDA(At, 1, 1); PG8_STAGE(PG8_SA(1, 0), a3, voffA);
            PG8_BAR; PG8_WAIT_L(0); PG8_MMA(1, 0, At, B0); PG8_BAR; PG8_SCHED;
            PG8_STAGE(PG8_SB(1, 1), b3 + hstep, voffB);
            PG8_WAIT_V(6); PG8_BAR; PG8_MMA(1, 1, At, B1); PG8_BAR;
            }
        }
        if constexpr (ALIGN_EPI) { if (wr == 0) PG8_BAR; }
        if constexpr (!Epi::AFTER_DRAIN) { E(acc, cur, wr, wc, fr, fq); S.done(cur); }
        if (!has_next) break;
#pragma unroll
        for (int a = 0; a < 2; ++a)
#pragma unroll
            for (int b = 0; b < 2; ++b)
#pragma unroll
                for (int m = 0; m < 4; ++m)
#pragma unroll
                    for (int n = 0; n < 2; ++n) acc[a][b][m][n] = (f32x4){0.f, 0.f, 0.f, 0.f};
        cur = nxt; cA = nA; cB = nB; ++ui;
        if constexpr (ALIGN_EPI) { if (wr == 1) PG8_BAR; }
    }
    PG8_WAIT_V(0);
    if constexpr (!ALIGN_EPI) { if (wr == 0) PG8_BAR; }
    PG8_BAR;
    if constexpr (Epi::AFTER_DRAIN) { E.fused(acc, cur, wr, wc, fr, fq, lds, wid, lane); S.done(cur); }
#undef PG8_SA
#undef PG8_SB
#undef PG8_STAGE
#undef PG8_LDA
#undef PG8_LDB
#undef PG8_MMA
#undef PG8_WAIT_V
#undef PG8_WAIT_L
#undef PG8_BAR
#undef PG8_SCHED
}
}
namespace pg8 {
__device__ __forceinline__ unsigned cvt_pk_bf16(float lo, float hi) { unsigned r; asm volatile("v_cvt_pk_bf16_f32 %0, %1, %2" : "=v"(r) : "v"(lo), "v"(hi)); return r; }
__device__ __forceinline__ u32x4 pack8(f32x4 v0, f32x4 v1) { u32x4 w; w.x = cvt_pk_bf16(v0[0], v0[1]); w.y = cvt_pk_bf16(v0[2], v0[3]); w.z = cvt_pk_bf16(v1[0], v1[1]); w.w = cvt_pk_bf16(v1[2], v1[3]); return w; }
__device__ __forceinline__ float sq4(f32x4 v) { return (v[0] * v[0] + v[1] * v[1]) + (v[2] * v[2] + v[3] * v[3]); }
constexpr int T_PROMPT = 16384;
struct EpiPlain {
    static constexpr bool PERM = true, AFTER_DRAIN = false, KSCALE = false;
    bf16_t* O; int ldc; int nfull; float* dt;
    __device__ __forceinline__ void operator()(const f32x4 (&acc)[2][2][4][2], const Unit& u, int wr, int wc, int fr, int fq) const {
        const int row0 = u.pm * BM + wr * 64 + fr;
        if (u.pn < nfull) {
            const int col0 = u.pn * BM + wc * 32 + 8 * fq;
#pragma unroll
            for (int ai = 0; ai < 2; ++ai)
#pragma unroll
                for (int m = 0; m < 4; ++m) { bf16_t* rowp = O + (size_t)(row0 + ai * HALF + m * 16) * ldc + col0;
#pragma unroll
                    for (int bj = 0; bj < 2; ++bj) *(u32x4*)(rowp + bj * HALF) = pack8(acc[ai][bj][m][0], acc[ai][bj][m][1]); }
        } else if (dt != nullptr && wc == 0 && fq < 2) {
#pragma unroll
            for (int ai = 0; ai < 2; ++ai)
#pragma unroll
                for (int m = 0; m < 4; ++m) { float* d = dt + (size_t)(row0 + ai * HALF + m * 16) * 16 + 8 * fq; *(f32x4*)d = acc[ai][0][m][0]; *(f32x4*)(d + 4) = acc[ai][0][m][1]; }
        }
    }
};
template <bool KS> struct EpiRes {
    static constexpr bool PERM = true, AFTER_DRAIN = false, KSCALE = KS;
    const unsigned long long* ssqg;
    __device__ __forceinline__ void kscale(f32x4 (&acc)[2][2][4][2], const Unit& u, int kd, int wr, int fr) const {
        const int row0 = u.pm * BM + wr * 64 + fr;
#pragma unroll
        for (int ai = 0; ai < 2; ++ai)
#pragma unroll
            for (int m = 0; m < 4; ++m) { const int row = row0 + ai * HALF + m * 16;
                const float r0 = rsqrtf((float)ssqg[2 * row] * (1.0f / (512.0f * 1048576.0f)) + 1e-6f), r1 = rsqrtf((float)ssqg[2 * row + 1] * (1.0f / (512.0f * 1048576.0f)) + 1e-6f);
                const float sc = (kd == 512) ? r0 / r1 : r1;
#pragma unroll
                for (int bj = 0; bj < 2; ++bj)
#pragma unroll
                    for (int n = 0; n < 2; ++n) acc[ai][bj][m][n] = acc[ai][bj][m][n] * sc; }
    }
    const float* base_p; const float* base_s; float* out; bf16_t* outb; unsigned long long* ssq;
    __device__ __forceinline__ void operator()(const f32x4 (&acc)[2][2][4][2], const Unit& u, int wr, int wc, int fr, int fq) const {
        const int row0 = u.pm * BM + wr * 64 + fr, col0 = u.pn * BM + wc * 32 + 8 * fq;
#pragma unroll
        for (int ai = 0; ai < 2; ++ai)
#pragma unroll
            for (int m = 0; m < 4; ++m) { const int row = row0 + ai * HALF + m * 16;
                const float* bp = (row < T_PROMPT) ? base_p + (size_t)row * 1024 : base_s + (size_t)(row - T_PROMPT) * 1024;
                float* op = out + (size_t)row * 1024; bf16_t* ob = outb + (size_t)row * 1024; float s = 0.f;
#pragma unroll
                for (int bj = 0; bj < 2; ++bj) { const int c = col0 + bj * HALF;
                    const f32x4 v0 = acc[ai][bj][m][0] + *(const f32x4*)(bp + c), v1 = acc[ai][bj][m][1] + *(const f32x4*)(bp + c + 4);
                    *(f32x4*)(op + c) = v0; *(f32x4*)(op + c + 4) = v1; *(u32x4*)(ob + c) = pack8(v0, v1); s += sq4(v0) + sq4(v1); }
                s += __shfl_xor(s, 16); s += __shfl_xor(s, 32);
                if (fq == 0) atomicAdd(ssq + row, (unsigned long long)(s * 1048576.0f)); }
    }
};
struct EpiGU {
    static constexpr bool PERM = true, AFTER_DRAIN = false, KSCALE = false;
    bf16_t* H; const unsigned long long* ssq;
    __device__ __forceinline__ void operator()(const f32x4 (&acc)[2][2][4][2], const Unit& u, int wr, int wc, int fr, int fq) const {
        const int row0 = u.pm * BM + wr * 64 + fr, col0 = u.pn * HALF + wc * 32 + 8 * fq;
#pragma unroll
        for (int ai = 0; ai < 2; ++ai)
#pragma unroll
            for (int m = 0; m < 4; ++m) { const int row = row0 + ai * HALF + m * 16;
                const float rstd = rsqrtf((float)ssq[row] * (1.0f / (1024.0f * 1048576.0f)) + 1e-6f);
                f32x4 o[2];
#pragma unroll
                for (int n = 0; n < 2; ++n) { const f32x4 g = acc[ai][0][m][n] * rstd, uu = acc[ai][1][m][n] * rstd;
#pragma unroll
                    for (int j = 0; j < 4; ++j) o[n][j] = g[j] * __builtin_amdgcn_rcpf(1.0f + __expf(-g[j])) * uu[j]; }
                *(u32x4*)(H + (size_t)row * 2816 + col0) = pack8(o[0], o[1]); }
    }
};
struct EpiPle {
    static constexpr bool PERM = true, AFTER_DRAIN = false, KSCALE = false;
    float* h; const bf16_t* pp; const unsigned long long* ssq2; unsigned long long* ssq3;
    __device__ __forceinline__ void operator()(const f32x4 (&acc)[2][2][4][2], const Unit& u, int wr, int wc, int fr, int fq) const {
        const int row0 = u.pm * BM + wr * 64 + fr, col0 = u.pn * BM + wc * 32 + 8 * fq;
#pragma unroll
        for (int ai = 0; ai < 2; ++ai)
#pragma unroll
            for (int m = 0; m < 4; ++m) { const int row = row0 + ai * HALF + m * 16;
                const float rstd = rsqrtf((float)ssq2[row] * (1.0f / (1024.0f * 1048576.0f)) + 1e-6f);
                float* hp = h + (size_t)row * 1024; const bf16_t* pr = pp + (size_t)row * 1024; float s = 0.f;
#pragma unroll
                for (int bj = 0; bj < 2; ++bj) { const int c = col0 + bj * HALF;
                    const u32x4 pw = *(const u32x4*)(pr + c);
                    f32x4 p0, p1; p0[0] = __uint_as_float(pw.x << 16); p0[1] = __uint_as_float(pw.x & 0xffff0000u); p0[2] = __uint_as_float(pw.y << 16); p0[3] = __uint_as_float(pw.y & 0xffff0000u);
                    p1[0] = __uint_as_float(pw.z << 16); p1[1] = __uint_as_float(pw.z & 0xffff0000u); p1[2] = __uint_as_float(pw.w << 16); p1[3] = __uint_as_float(pw.w & 0xffff0000u);
                    f32x4 v0 = *(const f32x4*)(hp + c), v1 = *(const f32x4*)(hp + c + 4);
                    const f32x4 a0 = acc[ai][bj][m][0] * rstd, a1 = acc[ai][bj][m][1] * rstd;
#pragma unroll
                    for (int j = 0; j < 4; ++j) { v0[j] += p0[j] * __builtin_amdgcn_rcpf(1.0f + __expf(-a0[j])); v1[j] += p1[j] * __builtin_amdgcn_rcpf(1.0f + __expf(-a1[j])); }
                    *(f32x4*)(hp + c) = v0; *(f32x4*)(hp + c + 4) = v1; s += sq4(v0) + sq4(v1); }
                s += __shfl_xor(s, 16); s += __shfl_xor(s, 32);
                if (fq == 0) atomicAdd(ssq3 + row, (unsigned long long)(s * 1048576.0f)); }
    }
};
}
#define LAS __attribute__((address_space(3)))
typedef pg8::bf16_t bf16_t;
typedef pg8::bf16x8 bf16x8;
typedef pg8::f32x4 f32x4;
typedef pg8::u32x4 u32x4;
typedef unsigned u32x2 __attribute__((ext_vector_type(2)));

constexpr int NT_P = 16384, NT_S = 1024, NT = NT_P + NT_S, DM = 1024;
constexpr int PP = 5888;
constexpr int NW_IN = 6144;
constexpr int DFF = 2816, PLE = 256, RWP = 3328, CONVD = 1536;
constexpr int COL_Z = 0, COL_XBC = 1024, COL_RW = 2560;
constexpr size_t MiB = 1u << 20;
constexpr size_t WS_SSQ1 = 0, WS_SSQ2 = 192 * 1024, WS_SSQ3 = 384 * 1024, WS_SSQG = 576 * 1024, WS_BAR = 896 * 1024, WS_ZERO_BYTES = 1 * MiB;
constexpr size_t WS_WIN = 1 * MiB, WS_WOUT = 13 * MiB, WS_WGU = 17 * MiB, WS_WDOWN = 28 * MiB, WS_WPLG = 34 * MiB, WS_WPLP = 36 * MiB;
constexpr size_t WS_W2T = 37 * MiB, WS_A2T = WS_W2T + 128 * 1024, WS_G2T = WS_W2T + 256 * 1024;
constexpr size_t WS_P = 40 * MiB;
constexpr size_t WS_ALO = 247 * MiB;
constexpr size_t WS_DT = 236 * MiB, WS_PB = 238 * MiB;
constexpr size_t WS_H = 40 * MiB, WS_HB = 108 * MiB, WS_FF = 142 * MiB;
static_assert(WS_P + (size_t)NT * PP * 2 <= WS_DT && WS_PB + (size_t)NT * PLE * 2 <= 256 * MiB && WS_FF + (size_t)NT * DFF * 2 <= WS_DT, "ws map");
constexpr size_t O_YP = 0, O_YS = 16777216, O_SSMP = 17825792, O_CONVP = 18874368, O_WKVP = 18911232, O_SHIFTP = 19435520,
                 O_SSMS = 19462144, O_CONVS = 36239360, O_WKVS = 36829184, O_SHIFTS = 45217792, O_END = 45643776;
constexpr int LDS_BYTES = 135168;

__device__ __forceinline__ float bflo(unsigned u) { return __uint_as_float(u << 16); }
__device__ __forceinline__ float bfhi(unsigned u) { return __uint_as_float(u & 0xffff0000u); }
__device__ __forceinline__ float bf1(bf16_t u) { return __uint_as_float(((unsigned)u) << 16); }
__device__ __forceinline__ unsigned pk2(float lo, float hi) { return pg8::cvt_pk_bf16(lo, hi); }
__device__ __forceinline__ float sigm(float x) { return __builtin_amdgcn_rcpf(1.0f + __expf(-x)); }
__device__ __forceinline__ float silu(float x) { return x * __builtin_amdgcn_rcpf(1.0f + __expf(-x)); }
__device__ __forceinline__ float tanh_fast(float x) { return 1.0f - 2.0f * __builtin_amdgcn_rcpf(__expf(2.0f * x) + 1.0f); }
__device__ __forceinline__ float softplus(float x) { const float e = __expf(-fabsf(x)); const float l = (e < 0.01f) ? e * (1.0f - e * (0.5f - e * 0.33333333f)) : __logf(1.0f + e); return fmaxf(x, 0.f) + l; }
__device__ __forceinline__ float wave_sum(float v) {
#pragma unroll
    for (int o = 1; o < 64; o <<= 1) v += __shfl_xor(v, o);
    return v;
}
template <int CTRL> __device__ __forceinline__ float dppf(float x) { return __int_as_float(__builtin_amdgcn_update_dpp(0, __float_as_int(x), CTRL, 0xf, 0xf, true)); }
__device__ __forceinline__ float half_sum(float v) {
    v += dppf<0xB1>(v); v += dppf<0x4E>(v); v += dppf<0x141>(v); v += dppf<0x140>(v);
    const float s0 = __int_as_float(__builtin_amdgcn_readlane(__float_as_int(v), 0)), s1 = __int_as_float(__builtin_amdgcn_readlane(__float_as_int(v), 16));
    const float s2 = __int_as_float(__builtin_amdgcn_readlane(__float_as_int(v), 32)), s3 = __int_as_float(__builtin_amdgcn_readlane(__float_as_int(v), 48));
    return ((threadIdx.x & 32) == 0) ? (s0 + s1) : (s2 + s3);
}
__device__ __forceinline__ float red8(float x) {
    x += dppf<0xB1>(x);
    x += dppf<0x4E>(x);
    x += dppf<0x141>(x);
    return x;
}
__device__ __forceinline__ float red16(float x) {
    x += dppf<0xB1>(x); x += dppf<0x4E>(x); x += dppf<0x141>(x); x += dppf<0x140>(x);
    return x;
}
typedef float f32x2v __attribute__((ext_vector_type(2)));
typedef _Float16 h2v __attribute__((ext_vector_type(2)));
typedef __fp16 fh2v __attribute__((ext_vector_type(2)));
__device__ __forceinline__ h2v toh2(unsigned u) { return __builtin_bit_cast(h2v, u); }
#define LBAR() asm volatile("s_waitcnt lgkmcnt(0)\n\ts_barrier" ::: "memory")
#define LDS_WAIT() asm volatile("s_waitcnt lgkmcnt(0)" ::: "memory")
__device__ __forceinline__ bf16x8 ldfrag(const LAS unsigned char* p) { return *(const LAS bf16x8*)p; }
__device__ __forceinline__ bf16x8 frag_from_f32(const LAS float* p) {
    const f32x4 a = *(const LAS f32x4*)p, b = *(const LAS f32x4*)(p + 4);
    return __builtin_bit_cast(bf16x8, pg8::pack8(a, b));
}
#define MFMA16(X, Y, ACC) __builtin_amdgcn_mfma_f32_16x16x32_bf16((X), (Y), (ACC), 0, 0, 0)

struct Args {
    const float* in[36]; float* out; unsigned char* ws;
};
typedef const __attribute__((address_space(4))) Args* CArgs;
__device__ __forceinline__ CArgs get_args() { CArgs p = (CArgs)__builtin_amdgcn_kernarg_segment_ptr(); asm volatile("" : "+s"(p)); return p; }
__device__ __forceinline__ int get_tid() { int t = threadIdx.x; asm volatile("" : "+v"(t)); return t; }

__device__ __forceinline__ int map_row(int code, int n) {
    if (code == 1) return n < 2560 ? n : (n < 2576 ? 5888 + (n - 2560) : n - 16);
    if (code == 2) return (n >> 7) * 256 + (n & 127);
    if (code == 3) return (n >> 7) * 256 + 128 + (n & 127);
    return n;
}
__device__ __forceinline__ void transpose_item(const float* __restrict__ W, int K, int N, bf16_t* WT, const float* __restrict__ gain, int gain_n, int code, LAS float* scr, int item, int lane) {
    const int nblk = (N + 31) / 32, kb = item / nblk, nb = item % nblk, k0 = 64 * kb, n0 = 32 * nb;
#pragma unroll 8
    for (int i = 0; i < 32; ++i) { const int kk = 2 * i + (lane >> 5), n = n0 + (lane & 31);
        float v = (n < N) ? W[(size_t)(k0 + kk) * N + n] : 0.f;
        if (gain != nullptr && (k0 + kk) < gain_n) v *= gain[k0 + kk];
        scr[kk * 33 + (lane & 31)] = v; }
    LDS_WAIT(); asm volatile("" ::: "memory");
    const int c = lane & 7;
#pragma unroll
    for (int j = 0; j < 4; ++j) { const int nl = (lane >> 3) + 8 * j, n = n0 + nl; const LAS float* s = scr + (8 * c) * 33 + nl;
        u32x4 o; o.x = pk2(s[0 * 33], s[1 * 33]); o.y = pk2(s[2 * 33], s[3 * 33]); o.z = pk2(s[4 * 33], s[5 * 33]); o.w = pk2(s[6 * 33], s[7 * 33]);
        if (n < N) *(u32x4*)(WT + (size_t)map_row(code, n) * K + k0 + 8 * c) = o; }
    LDS_WAIT(); asm volatile("" ::: "memory");
}
__device__ __forceinline__ void phase0b(LAS unsigned char* lds, int first_blk) {
    const CArgs ap = get_args();
    const int tid = get_tid(), lane = tid & 63, wave = tid >> 6;
    if ((int)blockIdx.x < first_blk) return;
    LAS float* scr = (LAS float*)(lds + wave * 16384);
    const int gw = ((int)blockIdx.x - first_blk) * 8 + wave, NGW = ((int)gridDim.x - first_blk) * 8;
    unsigned char* ws = ap->ws;
    int base = 0;
#define DO_MAT(SRC, K_, N_, DST, GAIN, GN, CODE) do { const int nitems = ((K_) / 64) * (((N_) + 31) / 32); int first = gw - (base % NGW); if (first < 0) first += NGW; \
        for (int it = first; it < nitems; it += NGW) transpose_item((SRC), (K_), (N_), (bf16_t*)(ws + (DST)), (GAIN), (GN), (CODE), scr, it, lane); base += nitems; } while (0)
    DO_MAT(ap->in[29], 1024, 2816, WS_WGU, ap->in[28], 1024, 2);
    DO_MAT(ap->in[30], 1024, 2816, WS_WGU, ap->in[28], 1024, 3);
    DO_MAT(ap->in[31], 2816, 1024, WS_WDOWN, nullptr, 0, 0);
    DO_MAT(ap->in[33], 1024, 1024, WS_WPLG, ap->in[32], 1024, 0);
    DO_MAT(ap->in[34], 256, 1024, WS_WPLP, nullptr, 0, 0);
#undef DO_MAT
}
__device__ __forceinline__ void phase0(LAS unsigned char* lds) {
    const CArgs ap = get_args();
    const int tid = get_tid(), lane = tid & 63, wave = tid >> 6;
    LAS float* scr = (LAS float*)(lds + wave * 16384);
    const int gw = blockIdx.x * 8 + wave, NGW = gridDim.x * 8;
    unsigned char* ws = ap->ws;
    int base = 0;
#define DO_MAT(SRC, K_, N_, DST, GAIN, GN, CODE) do { const int nitems = ((K_) / 64) * (((N_) + 31) / 32); int first = gw - (base % NGW); if (first < 0) first += NGW; \
        for (int it = first; it < nitems; it += NGW) transpose_item((SRC), (K_), (N_), (bf16_t*)(ws + (DST)), (GAIN), (GN), (CODE), scr, it, lane); base += nitems; } while (0)
    DO_MAT(ap->in[9], 1024, 5904, WS_WIN, nullptr, 0, 1);
    DO_MAT(ap->in[27], 2048, 1024, WS_WOUT, ap->in[15], 1024, 0);
    DO_MAT(ap->in[18], 64, 1024, WS_W2T, nullptr, 0, 0);
    DO_MAT(ap->in[20], 64, 1024, WS_A2T, nullptr, 0, 0);
    DO_MAT(ap->in[21], 128, 1024, WS_G2T, nullptr, 0, 0);
#undef DO_MAT
    bf16_t* xn = (bf16_t*)(ap->out + O_SSMS);
    const float* gmix = ap->in[8];
    f32x4 gv[4];
#pragma unroll
    for (int j = 0; j < 4; ++j) gv[j] = *(const f32x4*)(gmix + 4 * lane + 256 * j);
    for (int m = gw; m < NT; m += NGW) {
        const float* xr = (m < NT_P) ? ap->in[0] + (size_t)m * DM : ap->in[1] + (size_t)(m - NT_P) * DM;
        f32x4 v[4]; float s = 0.f;
#pragma unroll
        for (int j = 0; j < 4; ++j) { v[j] = *(const f32x4*)(xr + 4 * lane + 256 * j); s += pg8::sq4(v[j]); }
        const float rstd = rsqrtf(wave_sum(s) * (1.0f / DM) + 1e-6f);
#pragma unroll
        for (int j = 0; j < 4; ++j) { const f32x4 o = v[j] * rstd * gv[j]; u32x2 w; w.x = pk2(o[0], o[1]); w.y = pk2(o[2], o[3]); *(u32x2*)(xn + (size_t)m * DM + 4 * lane + 256 * j) = w; }
    }
    bf16_t* pb = (bf16_t*)(ws + WS_PB);
    for (int m = gw; m < NT; m += NGW) {
        const float* pr = (m < NT_P) ? ap->in[6] + (size_t)m * PLE : ap->in[7] + (size_t)(m - NT_P) * PLE;
        const f32x4 v = *(const f32x4*)(pr + 4 * lane); u32x2 w; w.x = pk2(v[0], v[1]); w.y = pk2(v[2], v[3]);
        *(u32x2*)(pb + (size_t)m * PLE + 4 * lane) = w;
    }
}
constexpr int US = 452;
__device__ __forceinline__ int rw_pcol(int cgp, int h) {
    return cgp < 8 ? COL_RW + h * 64 + 8 * cgp : cgp < 16 ? COL_RW + 1024 + h * 64 + 8 * (cgp - 8) : cgp < 24 ? COL_RW + 2048 + h * 64 + 8 * (cgp - 16) : COL_RW + 3072 + 8 * (cgp - 24);
}
__device__ __forceinline__ bool rw_item(int q, int tid, int& tok, int& cgp) {
    if (q == 0 && tid < 384) { tok = tid / 24; cgp = tid - tok * 24; return true; }
    return false;
}
__device__ __forceinline__ void phase_alo() {
    const CArgs ap = get_args();
    const int tid = get_tid();
    const bf16_t* __restrict__ P = (const bf16_t*)(ap->ws + WS_P);
    bf16_t* ALO = (bf16_t*)(ap->ws + WS_ALO);
    const float* __restrict__ mu = ap->in[16] + 3072; const float* __restrict__ sh = ap->in[5];
    for (int idx = blockIdx.x * 512 + tid; idx < NT * 32; idx += gridDim.x * 512) {
        const int row = idx >> 5, g = idx & 31, col = 8 * g;
        const u32x4 cw = *(const u32x4*)(P + (size_t)row * PP + COL_RW + 3072 + col);
        const int t = row < NT_P ? (row & 2047) : ((row - NT_P) & 7);
        float cur[8] = {bflo(cw.x), bfhi(cw.x), bflo(cw.y), bfhi(cw.y), bflo(cw.z), bfhi(cw.z), bflo(cw.w), bfhi(cw.w)}, prv[8];
        if (t > 0) { const u32x4 pw = *(const u32x4*)(P + (size_t)(row - 1) * PP + COL_RW + 3072 + col);
            prv[0] = bflo(pw.x); prv[1] = bfhi(pw.x); prv[2] = bflo(pw.y); prv[3] = bfhi(pw.y); prv[4] = bflo(pw.z); prv[5] = bfhi(pw.z); prv[6] = bflo(pw.w); prv[7] = bfhi(pw.w); }
        else if (row >= NT_P) { const float* sp = sh + (size_t)((row - NT_P) >> 3) * RWP + 3072 + col; const f32x4 s0a = *(const f32x4*)sp, s0b = *(const f32x4*)(sp + 4);
#pragma unroll
            for (int i = 0; i < 4; ++i) { prv[i] = s0a[i]; prv[4 + i] = s0b[i]; } }
        else {
#pragma unroll
            for (int i = 0; i < 8; ++i) prv[i] = 0.f; }
        const f32x4 m0 = *(const f32x4*)(mu + col), m1 = *(const f32x4*)(mu + col + 4);
        float o[8];
#pragma unroll
        for (int i = 0; i < 8; ++i) { const float m = i < 4 ? m0[i] : m1[i - 4]; float v = cur[i] + (prv[i] - cur[i]) * m;
            if (g < 8) v = tanh_fast(v); else if (g >= 16) v = sigm(v);
            o[i] = v; }
        u32x4 w; w.x = pk2(o[0], o[1]); w.y = pk2(o[2], o[3]); w.z = pk2(o[4], o[5]); w.w = pk2(o[6], o[7]);
        *(u32x4*)(ALO + (size_t)row * 256 + col) = w;
    }
}
template <bool PROMPT> __device__ __forceinline__ void rwkv_task(LAS unsigned char* lds, CArgs ap, int h, int row0, int L, const float* __restrict__ s0, const float* __restrict__ shift0, float* __restrict__ sout) {
    const bf16_t* __restrict__ P = (const bf16_t*)(ap->ws + WS_P);
    bf16_t* Y = (bf16_t*)ap->out;
    const float* __restrict__ mu = ap->in[16];
    LAS float* U = (LAS float*)lds;
    LAS float* Wd = U + 16 * US; LAS float* Aa = Wd + 1024; LAS float* Gg = Aa + 1024; LAS float* KK = Gg + 1024; LAS float* KKA = KK + 1024; LAS float* KP = KKA + 1024; LAS float* Oo = KP + 1024; LAS float* SB = Oo + 1024; LAS float* OoP = SB + 64; LAS unsigned* V2 = (LAS unsigned*)(OoP + 8192);
    LAS _Float16* Wd16 = (LAS _Float16*)Wd; LAS _Float16* KK16 = (LAS _Float16*)KK; LAS _Float16* KKA16 = (LAS _Float16*)KKA; LAS _Float16* KP16 = (LAS _Float16*)KP; LAS _Float16* R16 = (LAS _Float16*)Oo;
    const int tid = get_tid(), lane = tid & 63, wave = tid >> 6;
    const int tokl = lane & 15, kq = 8 * (lane >> 4), ct = wave & 3;
    bf16x8 wf[4];
    {
        const int col = h * 64 + 16 * ct + tokl;
        if (wave < 4) {
            const bf16_t* w2t = (const bf16_t*)(ap->ws + WS_W2T) + (size_t)col * 64 + kq; const bf16_t* a2t = (const bf16_t*)(ap->ws + WS_A2T) + (size_t)col * 64 + kq;
            wf[0] = *(const bf16x8*)w2t; wf[1] = *(const bf16x8*)(w2t + 32); wf[2] = *(const bf16x8*)a2t; wf[3] = *(const bf16x8*)(a2t + 32);
        } else {
            const bf16_t* g2t = (const bf16_t*)(ap->ws + WS_G2T) + (size_t)col * 128 + kq;
#pragma unroll
            for (int s = 0; s < 4; ++s) wf[s] = *(const bf16x8*)(g2t + 32 * s);
        }
    }
    const int ecol = h * 64 + 16 * ct + 4 * (lane >> 4);
    const f32x4 w0v = *(const f32x4*)(ap->in[17] + ecol), a0v = *(const f32x4*)(ap->in[19] + ecol);
    const int etok = tid >> 5, c2 = 2 * (tid & 31), gc = h * 64 + c2;
    const float kkw0 = ap->in[22][gc], kkw1 = ap->in[22][gc + 1], ka0 = ap->in[23][gc], ka1 = ap->in[23][gc + 1], rk0 = ap->in[24][gc], rk1 = ap->in[24][gc + 1];
    const float lnw0 = ap->in[25][gc], lnw1 = ap->in[25][gc + 1], lnb0 = ap->in[26][gc], lnb1 = ap->in[26][gc + 1];
    const int rl = lane >> 3, kg = lane & 7, srow = wave * 8 + rl;
    h2v S2[4];
    if (s0 != nullptr) { const f32x4 x0 = *(const f32x4*)(s0 + srow * 64 + 8 * kg), x1 = *(const f32x4*)(s0 + srow * 64 + 8 * kg + 4);
        S2[0] = (h2v){(_Float16)x0[0], (_Float16)x0[1]}; S2[1] = (h2v){(_Float16)x0[2], (_Float16)x0[3]}; S2[2] = (h2v){(_Float16)x1[0], (_Float16)x1[1]}; S2[3] = (h2v){(_Float16)x1[2], (_Float16)x1[3]}; }
    else {
#pragma unroll
        for (int i = 0; i < 4; ++i) S2[i] = (h2v){(_Float16)0.f, (_Float16)0.f}; }
    const int nchunk = (L + 15) / 16;
    u32x4 rc[2], rp[2];
#define RW_LOAD(C) do { _Pragma("unroll") for (int q = 0; q < 2; ++q) { int tok, cgp; rc[q] = (u32x4){0u, 0u, 0u, 0u}; rp[q] = (u32x4){0u, 0u, 0u, 0u}; \
        if (rw_item(q, tid, tok, cgp)) { const int t = 16 * (C) + tok; const int pc = rw_pcol(cgp, h); \
            if (t < L) { rc[q] = *(const u32x4*)(P + (size_t)(row0 + t) * PP + pc); if (t > 0) rp[q] = *(const u32x4*)(P + (size_t)(row0 + t - 1) * PP + pc); } } } } while (0)
    f32x4 muv[2][2];
#pragma unroll
    for (int q = 0; q < 2; ++q) { int tok, cgp; muv[q][0] = (f32x4){0.f, 0.f, 0.f, 0.f}; muv[q][1] = muv[q][0];
        if (rw_item(q, tid, tok, cgp)) { const int mj = rw_pcol(cgp, h) - COL_RW; muv[q][0] = *(const f32x4*)(mu + mj); muv[q][1] = *(const f32x4*)(mu + mj + 4); } }
    const bf16_t* __restrict__ ALO = (const bf16_t*)(ap->ws + WS_ALO);
    bf16x8 af[4];
#define AF_LOAD(C) do { int r_ = row0 + 16 * (C) + tokl; r_ = r_ < NT ? r_ : NT - 1; const bf16_t* ar_ = ALO + (size_t)r_ * 256 + kq; \
        if (wave < 4) { af[0] = *(const bf16x8*)ar_; af[1] = *(const bf16x8*)(ar_ + 32); af[2] = *(const bf16x8*)(ar_ + 64); af[3] = *(const bf16x8*)(ar_ + 96); } \
        else { af[0] = *(const bf16x8*)(ar_ + 128); af[1] = *(const bf16x8*)(ar_ + 160); af[2] = *(const bf16x8*)(ar_ + 192); af[3] = *(const bf16x8*)(ar_ + 224); } } while (0)
    AF_LOAD(0);
    RW_LOAD(0);
    for (int c = 0; c < nchunk; ++c) {
#pragma unroll
        for (int q = 0; q < 2; ++q) { int tok, cgp;
            if (rw_item(q, tid, tok, cgp)) { const int t = 16 * c + tok; const int mj = rw_pcol(cgp, h) - COL_RW;
                float cur[8], prv[8];
                cur[0] = bflo(rc[q].x); cur[1] = bfhi(rc[q].x); cur[2] = bflo(rc[q].y); cur[3] = bfhi(rc[q].y); cur[4] = bflo(rc[q].z); cur[5] = bfhi(rc[q].z); cur[6] = bflo(rc[q].w); cur[7] = bfhi(rc[q].w);
                prv[0] = bflo(rp[q].x); prv[1] = bfhi(rp[q].x); prv[2] = bflo(rp[q].y); prv[3] = bfhi(rp[q].y); prv[4] = bflo(rp[q].z); prv[5] = bfhi(rp[q].z); prv[6] = bflo(rp[q].w); prv[7] = bfhi(rp[q].w);
                if (t == 0 && shift0 != nullptr) { const f32x4 s0a = *(const f32x4*)(shift0 + mj), s0b = *(const f32x4*)(shift0 + mj + 4);
#pragma unroll
                    for (int i = 0; i < 4; ++i) { prv[i] = s0a[i]; prv[4 + i] = s0b[i]; } }
                const f32x4 m0 = muv[q][0], m1 = muv[q][1];
                float o[8];
#pragma unroll
                for (int i = 0; i < 8; ++i) { const float m = i < 4 ? m0[i] : m1[i - 4]; float v = cur[i] + (prv[i] - cur[i]) * m;
                    if (q == 1) { if (tid < 128) v = tanh_fast(v); else v = sigm(v); }
                    o[i] = (PROMPT || t < L) ? v : 0.f; }
                *(LAS f32x4*)(U + tok * US + 8 * cgp) = (f32x4){o[0], o[1], o[2], o[3]}; *(LAS f32x4*)(U + tok * US + 8 * cgp + 4) = (f32x4){o[4], o[5], o[6], o[7]}; } }
        if (c + 1 < nchunk) RW_LOAD(c + 1);
        if (wave < 4) {
            f32x4 accw = {0.f, 0.f, 0.f, 0.f}, acca = {0.f, 0.f, 0.f, 0.f};
#pragma unroll
            for (int s = 0; s < 2; ++s) { accw = MFMA16(wf[s], af[s], accw); acca = MFMA16(wf[2 + s], af[2 + s], acca); }
            f32x4 dv, av;
#pragma unroll
            for (int j = 0; j < 4; ++j) { const float x = w0v[j] + accw[j]; dv[j] = __expf(-0.60653066f * sigm(x)); av[j] = sigm(a0v[j] + acca[j]); }
            *(LAS h2v*)(Wd16 + tokl * 64 + 16 * ct + 4 * (lane >> 4)) = (h2v){(_Float16)dv[0], (_Float16)dv[1]}; *(LAS h2v*)(Wd16 + tokl * 64 + 16 * ct + 4 * (lane >> 4) + 2) = (h2v){(_Float16)dv[2], (_Float16)dv[3]};
            *(LAS f32x4*)(Aa + tokl * 64 + 16 * ct + 4 * (lane >> 4)) = av;
        } else {
            f32x4 accg = {0.f, 0.f, 0.f, 0.f};
#pragma unroll
            for (int s = 0; s < 4; ++s) accg = MFMA16(wf[s], af[s], accg);
            *(LAS f32x4*)(Gg + tokl * 64 + 16 * ct + 4 * (lane >> 4)) = accg;
        }
        LBAR();
        if (c + 1 < nchunk) AF_LOAD(c + 1);
        {
            const float k0 = U[etok * US + 64 + c2], k1 = U[etok * US + 64 + c2 + 1], av0 = Aa[etok * 64 + c2], av1 = Aa[etok * 64 + c2 + 1];
            const float r0 = U[etok * US + c2], r1 = U[etok * US + c2 + 1];
            float q0 = k0 * kkw0, q1 = k1 * kkw1;
            const float ss = half_sum(q0 * q0 + q1 * q1);
            const float inv = fminf(rsqrtf(ss), 1e12f);
            q0 *= inv; q1 *= inv;
            const float kp0 = k0 * (1.0f + (av0 - 1.0f) * ka0), kp1 = k1 * (1.0f + (av1 - 1.0f) * ka1);
            { const float v0_ = U[etok * US + 128 + c2], v1_ = U[etok * US + 128 + c2 + 1];
              V2[etok * 64 + c2] = __builtin_bit_cast(unsigned, __builtin_amdgcn_cvt_pkrtz(v0_, v0_)); V2[etok * 64 + c2 + 1] = __builtin_bit_cast(unsigned, __builtin_amdgcn_cvt_pkrtz(v1_, v1_)); }
            *(LAS h2v*)(KK16 + etok * 64 + c2) = (h2v){(_Float16)q0, (_Float16)q1}; *(LAS h2v*)(KKA16 + etok * 64 + c2) = (h2v){(_Float16)(q0 * av0), (_Float16)(q1 * av1)};
            *(LAS h2v*)(KP16 + etok * 64 + c2) = (h2v){(_Float16)kp0, (_Float16)kp1}; *(LAS h2v*)(R16 + etok * 64 + c2) = (h2v){(_Float16)r0, (_Float16)r1};
            const float sb = half_sum(r0 * kp0 * rk0 + r1 * kp1 * rk1);
            if ((tid & 31) == 0) SB[etok] = sb;
        }
        LBAR();
        const int nv = PROMPT ? 16 : ((L - 16 * c) < 16 ? (L - 16 * c) : 16);
        u32x4 opA[5], opB[5]; unsigned vA, vB;
#define RW_OPS(DST, VD, TOK) do { DST[0] = *(const LAS u32x4*)(Wd16 + (TOK) * 64 + 8 * kg); DST[1] = *(const LAS u32x4*)(KK16 + (TOK) * 64 + 8 * kg); \
            DST[2] = *(const LAS u32x4*)(KKA16 + (TOK) * 64 + 8 * kg); DST[3] = *(const LAS u32x4*)(KP16 + (TOK) * 64 + 8 * kg); \
            DST[4] = *(const LAS u32x4*)(R16 + (TOK) * 64 + 8 * kg); VD = V2[(TOK) * 64 + srow]; } while (0)
#define H2(X, I) toh2((X)[I])
#define FD2(A, B, C) __builtin_amdgcn_fdot2(__builtin_bit_cast(fh2v, (A)), __builtin_bit_cast(fh2v, (B)), (C), false)
#define RW_STEP(SRC, VS, TOK) do { \
            float sk_ = FD2(S2[0], H2(SRC[1], 0), 0.f); sk_ = FD2(S2[1], H2(SRC[1], 1), sk_); sk_ = FD2(S2[2], H2(SRC[1], 2), sk_); sk_ = FD2(S2[3], H2(SRC[1], 3), sk_); \
            sk_ = red8(sk_); \
            const h2v nsk_ = __builtin_bit_cast(h2v, __builtin_amdgcn_cvt_pkrtz(-sk_, -sk_)), vv_ = toh2(VS); \
            _Pragma("unroll") for (int i = 0; i < 4; ++i) { h2v t_ = vv_ * H2(SRC[3], i); t_ = nsk_ * H2(SRC[2], i) + t_; S2[i] = S2[i] * H2(SRC[0], i) + t_; } \
            float q_ = FD2(S2[0], H2(SRC[4], 0), 0.f); q_ = FD2(S2[1], H2(SRC[4], 1), q_); q_ = FD2(S2[2], H2(SRC[4], 2), q_); q_ = FD2(S2[3], H2(SRC[4], 3), q_); \
            OoP[((TOK) * 64 + srow) * 8 + kg] = q_; } while (0)
        RW_OPS(opA, vA, 0);
#pragma unroll 1
        for (int tok = 0; tok < nv; tok += 4) {
            RW_OPS(opB, vB, tok + 1);
            RW_STEP(opA, vA, tok);
            RW_OPS(opA, vA, tok + 2);
            RW_STEP(opB, vB, tok + 1);
            RW_OPS(opB, vB, tok + 3);
            RW_STEP(opA, vA, tok + 2);
            RW_OPS(opA, vA, (tok + 4) & 15);
            RW_STEP(opB, vB, tok + 3);
        }
#undef RW_OPS
#undef RW_STEP
#undef H2
#undef FD2
        LBAR();
        {
            float o0, o1;
            { const LAS f32x4* op_ = (const LAS f32x4*)(OoP + (etok * 64 + c2) * 8); const f32x4 a0 = op_[0], a1 = op_[1], b0 = op_[2], b1 = op_[3];
              o0 = ((a0[0] + a0[1]) + (a0[2] + a0[3])) + ((a1[0] + a1[1]) + (a1[2] + a1[3])); o1 = ((b0[0] + b0[1]) + (b0[2] + b0[3])) + ((b1[0] + b1[1]) + (b1[2] + b1[3])); }
            const float mean = half_sum(o0 + o1) * (1.0f / 64.0f);
            const float d0 = o0 - mean, d1 = o1 - mean;
            const float var = half_sum(d0 * d0 + d1 * d1) * (1.0f / 64.0f);
            const float rs = rsqrtf(var + 64e-5f);
            const float sb = SB[etok], v0 = U[etok * US + 128 + c2], v1 = U[etok * US + 128 + c2 + 1];
            const float y0 = (d0 * rs * lnw0 + lnb0 + sb * v0) * Gg[etok * 64 + c2], y1 = (d1 * rs * lnw1 + lnb1 + sb * v1) * Gg[etok * 64 + c2 + 1];
            if (etok < nv) *(unsigned*)(Y + (size_t)(row0 + 16 * c + etok) * 2048 + 1024 + gc) = pk2(y0, y1);
        }
        LBAR();
    }
#undef RW_LOAD
#undef AF_LOAD
    *(f32x4*)(sout + srow * 64 + 8 * kg) = (f32x4){(float)S2[0].x, (float)S2[0].y, (float)S2[1].x, (float)S2[1].y}; *(f32x4*)(sout + srow * 64 + 8 * kg + 4) = (f32x4){(float)S2[2].x, (float)S2[2].y, (float)S2[3].x, (float)S2[3].y};
}
constexpr int S_CS = 0, S_BS = 17408, S_BT = 34816, S_XT = 53248, S_XW = 62464, S_SB = 71680, S_FL = 89088;
__device__ __forceinline__ void ssd_prompt_task(LAS unsigned char* lds, CArgs ap, int b, int h) {
    const bf16_t* __restrict__ P = (const bf16_t*)(ap->ws + WS_P);
    const float* __restrict__ dtraw = (const float*)(ap->ws + WS_DT);
    bf16_t* Y = (bf16_t*)ap->out;
    unsigned long long* ssqg = (unsigned long long*)(ap->ws + WS_SSQG);
    const int tid = get_tid(), lane = tid & 63, wave = tid >> 6, g = h >> 3;
    const int row0 = b * 2048;
    LAS float* acum = (LAS float*)(lds + S_FL); LAS float* dtv = acum + 64; LAS float* wgt = dtv + 64; LAS float* eac = wgt + 64; LAS float* misc = eac + 64;
    const float ah = -__expf(ap->in[13][h]), dtb = ap->in[12][h], Dh = ap->in[14][h];
    const int grp = tid % 80, run = tid / 80;
    int kind, pc, cc, loc;
    if (grp < 16) { kind = 0; loc = 4 * grp; pc = COL_XBC + h * 64 + loc; cc = h * 64 + loc; }
    else if (grp < 48) { kind = 1; loc = 4 * (grp - 16); pc = COL_XBC + 1024 + g * 128 + loc; cc = 1024 + g * 128 + loc; }
    else { kind = 2; loc = 4 * (grp - 48); pc = COL_XBC + 1280 + g * 128 + loc; cc = 1280 + g * 128 + loc; }
    f32x4 cw[4], cb;
    if (tid < 320) {
#pragma unroll
        for (int j = 0; j < 4; ++j) cw[j] = *(const f32x4*)(ap->in[10] + j * CONVD + cc);
        cb = *(const f32x4*)(ap->in[11] + cc);
    }
    const int tl = lane & 15, kq = 8 * (lane >> 4), q4 = 4 * (lane >> 4);
    const int qt = wave & 3, w2 = wave >> 2;
    f32x4 Sacc[4];
#pragma unroll
    for (int i = 0; i < 4; ++i) Sacc[i] = (f32x4){0.f, 0.f, 0.f, 0.f};
    for (int i = tid; i < 17408 / 4; i += 512) ((LAS unsigned*)(lds + S_SB))[i] = 0u;
    u32x2 raw[19];
#define RAWLD(CK) do { const int tb_ = 64 * (CK) + 16 * run - 3; _Pragma("unroll") for (int j = 0; j < 19; ++j) { const int t_ = tb_ + j; raw[j] = (u32x2){0u, 0u}; \
        if (t_ >= 0) raw[j] = *(const u32x2*)(P + (size_t)(row0 + t_) * PP + pc); } } while (0)
#define RAWF(J) ((f32x4){bflo(raw[J].x), bfhi(raw[J].x), bflo(raw[J].y), bfhi(raw[J].y)})
    if (tid < 320) RAWLD(0);
    for (int ck = 0; ck < 32; ++ck) {
        const int t0 = 64 * ck;
        if (tid < 320) {
            f32x4 r0, r1, r2;
            r0 = RAWF(0); r1 = RAWF(1); r2 = RAWF(2);
#pragma unroll
            for (int i = 0; i < 16; i += 2) {
                const f32x4 r3 = RAWF(3 + i), r4 = RAWF(4 + i);
                f32x4 oa = cb + cw[0] * r0 + cw[1] * r1 + cw[2] * r2 + cw[3] * r3;
                f32x4 ob = cb + cw[0] * r1 + cw[1] * r2 + cw[2] * r3 + cw[3] * r4;
#pragma unroll
                for (int j = 0; j < 4; ++j) { oa[j] = silu(oa[j]); ob[j] = silu(ob[j]); }
                const int tok = 16 * run + i;
                if (kind == 0) {
#pragma unroll
                    for (int j = 0; j < 4; ++j) *(LAS unsigned*)(lds + S_XT + (loc + j) * 144 + tok * 2) = pk2(oa[j], ob[j]);
                } else if (kind == 1) {
                    u32x2 wa, wb; wa.x = pk2(oa[0], oa[1]); wa.y = pk2(oa[2], oa[3]); wb.x = pk2(ob[0], ob[1]); wb.y = pk2(ob[2], ob[3]);
                    *(LAS u32x2*)(lds + S_BS + tok * 272 + loc * 2) = wa; *(LAS u32x2*)(lds + S_BS + (tok + 1) * 272 + loc * 2) = wb;
#pragma unroll
                    for (int j = 0; j < 4; ++j) *(LAS unsigned*)(lds + S_BT + (loc + j) * 144 + tok * 2) = pk2(oa[j], ob[j]);
                } else {
                    u32x2 wa, wb; wa.x = pk2(oa[0], oa[1]); wa.y = pk2(oa[2], oa[3]); wb.x = pk2(ob[0], ob[1]); wb.y = pk2(ob[2], ob[3]);
                    *(LAS u32x2*)(lds + S_CS + tok * 272 + loc * 2) = wa; *(LAS u32x2*)(lds + S_CS + (tok + 1) * 272 + loc * 2) = wb;
                }
                r0 = r2; r1 = r3; r2 = r4;
            }
            if (ck + 1 < 32) RAWLD(ck + 1);
        } else if (tid < 384) {
            const int tok = tid - 320;
            const float dt = softplus(dtraw[(size_t)(row0 + t0 + tok) * 16 + h] + dtb);
            float ac = dt * ah;
#pragma unroll
            for (int o = 1; o < 64; o <<= 1) { const float n = __shfl_up(ac, o); if (tok >= o) ac += n; }
            const float last = __shfl(ac, 63);
            acum[tok] = ac; dtv[tok] = dt; wgt[tok] = __expf(last - ac) * dt; eac[tok] = __expf(ac);
            if (tok == 0) misc[0] = __expf(last);
        }
        LBAR();
        { const int p = tid >> 3, s0 = (tid & 7) * 8; const u32x4 xv = *(const LAS u32x4*)(lds + S_XT + p * 144 + s0 * 2);
          const f32x4 wa = *(const LAS f32x4*)(wgt + s0), wb = *(const LAS f32x4*)(wgt + s0 + 4);
          u32x4 o; o.x = pk2(bflo(xv.x) * wa[0], bfhi(xv.x) * wa[1]); o.y = pk2(bflo(xv.y) * wa[2], bfhi(xv.y) * wa[3]); o.z = pk2(bflo(xv.z) * wb[0], bfhi(xv.z) * wb[1]); o.w = pk2(bflo(xv.w) * wb[2], bfhi(xv.w) * wb[3]);
          *(LAS u32x4*)(lds + S_XW + p * 144 + s0 * 2) = o; }
        u32x2 zpre[2];
#pragma unroll
        for (int i = 0; i < 2; ++i) zpre[i] = *(const u32x2*)(P + (size_t)(row0 + t0 + 16 * qt + tl) * PP + COL_Z + h * 64 + 16 * (2 * w2 + i) + q4);
        f32x4 G[2], Yc[2];
#pragma unroll
        for (int i = 0; i < 2; ++i) { G[i] = (f32x4){0.f, 0.f, 0.f, 0.f}; Yc[i] = (f32x4){0.f, 0.f, 0.f, 0.f}; }
#pragma unroll
        for (int ks = 0; ks < 4; ++ks) {
            const bf16x8 cf = ldfrag(lds + S_CS + (16 * qt + tl) * 272 + (32 * ks + kq) * 2);
#pragma unroll
            for (int i = 0; i < 2; ++i) {
                const int t2 = 2 * w2 + i;
                if (t2 <= qt) G[i] = MFMA16(ldfrag(lds + S_BS + (16 * t2 + tl) * 272 + (32 * ks + kq) * 2), cf, G[i]);
                Yc[i] = MFMA16(ldfrag(lds + S_SB + (16 * t2 + tl) * 272 + (32 * ks + kq) * 2), cf, Yc[i]);
            }
        }
        LBAR();
        {
            const int q = 16 * qt + tl; const float aq = acum[q], eq = eac[q];
#pragma unroll
            for (int i = 0; i < 2; ++i) { const int sb = 16 * (2 * w2 + i) + q4; float wv[4];
#pragma unroll
                for (int j = 0; j < 4; ++j) { const int s = sb + j; wv[j] = (s <= q) ? G[i][j] * __expf(aq - acum[s]) * dtv[s] : 0.f; }
                u32x2 o; o.x = pk2(wv[0], wv[1]); o.y = pk2(wv[2], wv[3]);
                *(LAS u32x2*)(lds + S_BS + q * 144 + sb * 2) = o;
                Yc[i] = Yc[i] * eq; }
        }
        LBAR();
        const float dec = misc[0];
#pragma unroll
        for (int i = 0; i < 4; ++i) Sacc[i] = Sacc[i] * dec;
#pragma unroll
        for (int ks = 0; ks < 2; ++ks) {
            const bf16x8 wfr = ldfrag(lds + S_BS + (16 * qt + tl) * 144 + (32 * ks + kq) * 2);
            const bf16x8 xwf = ldfrag(lds + S_XW + (16 * qt + tl) * 144 + (32 * ks + kq) * 2);
#pragma unroll
            for (int i = 0; i < 2; ++i) Yc[i] = MFMA16(ldfrag(lds + S_XT + (16 * (2 * w2 + i) + tl) * 144 + (32 * ks + kq) * 2), wfr, Yc[i]);
#pragma unroll
            for (int i = 0; i < 4; ++i) Sacc[i] = MFMA16(ldfrag(lds + S_BT + (16 * (4 * w2 + i) + tl) * 144 + (32 * ks + kq) * 2), xwf, Sacc[i]);
        }
        {
            const int q = 16 * qt + tl; const size_t grow = (size_t)(row0 + t0 + q);
            float ssl = 0.f;
#pragma unroll
            for (int i = 0; i < 2; ++i) { const int p0 = 16 * (2 * w2 + i) + q4;
                const u32x2 zw = zpre[i];
                const float z[4] = {bflo(zw.x), bfhi(zw.x), bflo(zw.y), bfhi(zw.y)}; float yv[4];
#pragma unroll
                for (int j = 0; j < 4; ++j) { const float xv = bf1(*(const LAS bf16_t*)(lds + S_XT + (p0 + j) * 144 + q * 2)); yv[j] = (Yc[i][j] + Dh * xv) * silu(z[j]); }
                u32x2 o; o.x = pk2(yv[0], yv[1]); o.y = pk2(yv[2], yv[3]);
                *(u32x2*)(Y + grow * 2048 + h * 64 + p0) = o;
                ssl += bflo(o.x) * bflo(o.x) + bfhi(o.x) * bfhi(o.x) + bflo(o.y) * bflo(o.y) + bfhi(o.y) * bfhi(o.y); }
            ssl += __shfl_xor(ssl, 16); ssl += __shfl_xor(ssl, 32);
            if (lane < 16) atomicAdd(ssqg + 2 * grow + g, (unsigned long long)(ssl * 1048576.0f));
        }
#pragma unroll
        for (int i = 0; i < 4; ++i) { u32x2 o; o.x = pk2(Sacc[i][0], Sacc[i][1]); o.y = pk2(Sacc[i][2], Sacc[i][3]);
            *(LAS u32x2*)(lds + S_SB + (16 * qt + tl) * 272 + (16 * (4 * w2 + i) + q4) * 2) = o; }
        LBAR();
    }
#undef RAWLD
#undef RAWF
    float* so = ap->out + O_SSMP + ((size_t)(b * 16 + h) * 64) * 128;
#pragma unroll
    for (int i = 0; i < 4; ++i) *(f32x4*)(so + (size_t)(16 * qt + tl) * 128 + 16 * (4 * w2 + i) + q4) = Sacc[i];
}
__device__ __forceinline__ void ssd_sample_task(LAS unsigned char* lds, CArgs ap, int b, int h) {
    const bf16_t* __restrict__ P = (const bf16_t*)(ap->ws + WS_P);
    const float* __restrict__ dtraw = (const float*)(ap->ws + WS_DT);
    bf16_t* Y = (bf16_t*)ap->out;
    unsigned long long* ssqg = (unsigned long long*)(ap->ws + WS_SSQG);
    const int tid = get_tid(), g = h >> 3, row0 = NT_P + 8 * b;
    LAS float* xs = (LAS float*)lds; LAS float* Bv = xs + 8 * 64; LAS float* Cv = Bv + 8 * 128; LAS float* dts = Cv + 8 * 128; LAS float* dAs = dts + 8;
    const float ah = -__expf(ap->in[13][h]), dtb = ap->in[12][h], Dh = ap->in[14][h];
    const int p = tid >> 3, ng = tid & 7, n0 = 16 * ng;
    f32x4 sv[4];
    { const float* sp = ap->in[2] + ((size_t)(b * 16 + h) * 64 + p) * 128 + n0;
#pragma unroll
      for (int i = 0; i < 4; ++i) sv[i] = *(const f32x4*)(sp + 4 * i); }
    float zv[8];
#pragma unroll
    for (int t = 0; t < 8; ++t) zv[t] = bf1(P[(size_t)(row0 + t) * PP + COL_Z + h * 64 + p]);
    if (tid < 320) {
        int pc, cc; LAS float* dst; int dstride;
        if (tid < 64) { pc = COL_XBC + h * 64 + tid; cc = h * 64 + tid; dst = xs + tid; dstride = 64; }
        else if (tid < 192) { const int n = tid - 64; pc = COL_XBC + 1024 + g * 128 + n; cc = 1024 + g * 128 + n; dst = Bv + n; dstride = 128; }
        else { const int n = tid - 192; pc = COL_XBC + 1280 + g * 128 + n; cc = 1280 + g * 128 + n; dst = Cv + n; dstride = 128; }
        const float* cwp = ap->in[10] + cc; const float w0 = cwp[0], w1 = cwp[CONVD], w2 = cwp[2 * CONVD], w3 = cwp[3 * CONVD], cb = ap->in[11][cc];
        const float* hs = ap->in[3] + (size_t)b * 3 * CONVD + cc;
        float r0 = hs[0], r1 = hs[CONVD], r2 = hs[2 * CONVD];
#pragma unroll
        for (int t = 0; t < 8; ++t) { const float r3 = bf1(P[(size_t)(row0 + t) * PP + pc]); dst[t * dstride] = silu(cb + w0 * r0 + w1 * r1 + w2 * r2 + w3 * r3); r0 = r1; r1 = r2; r2 = r3; }
    } else if (tid < 328) { const int t = tid - 320; const float dt = softplus(dtraw[(size_t)(row0 + t) * 16 + h] + dtb); dts[t] = dt; dAs[t] = __expf(dt * ah); }
    LBAR();
    float S[16];
#pragma unroll
    for (int i = 0; i < 4; ++i) { S[4 * i] = sv[i][0]; S[4 * i + 1] = sv[i][1]; S[4 * i + 2] = sv[i][2]; S[4 * i + 3] = sv[i][3]; }
#pragma unroll
    for (int t = 0; t < 8; ++t) {
        const float dA = dAs[t], xv = xs[t * 64 + p], xdt = xv * dts[t]; float y = 0.f;
#pragma unroll
        for (int i = 0; i < 4; ++i) { const f32x4 bv = *(const LAS f32x4*)(Bv + t * 128 + n0 + 4 * i), cv = *(const LAS f32x4*)(Cv + t * 128 + n0 + 4 * i);
#pragma unroll
            for (int j = 0; j < 4; ++j) { S[4 * i + j] = S[4 * i + j] * dA + xdt * bv[j]; y += S[4 * i + j] * cv[j]; } }
        y = red8(y);
        float ysq = 0.f;
        if (ng == 0) { const float yv = (y + Dh * xv) * silu(zv[t]);
            const bf16_t yb = (bf16_t)(pk2(yv, 0.f) & 0xffffu); Y[(size_t)(row0 + t) * 2048 + h * 64 + p] = yb; ysq = bf1(yb) * bf1(yb); }
        ysq += dppf<0x128>(ysq);
        ysq += __shfl_xor(ysq, 16); ysq += __shfl_xor(ysq, 32);
        if ((tid & 63) == 0) atomicAdd(ssqg + 2 * (size_t)(row0 + t) + g, (unsigned long long)(ysq * 1048576.0f));
    }
    float* so = ap->out + O_SSMS + ((size_t)(b * 16 + h) * 64 + p) * 128 + n0;
#pragma unroll
    for (int i = 0; i < 4; ++i) *(f32x4*)(so + 4 * i) = (f32x4){S[4 * i], S[4 * i + 1], S[4 * i + 2], S[4 * i + 3]};
    LBAR();
}
__device__ __forceinline__ void copy_states(CArgs ap, int part, int nparts) {
    const int tid = get_tid();
    const bf16_t* __restrict__ P = (const bf16_t*)(ap->ws + WS_P);
    float* out = ap->out;
    constexpr int PER = 3 * CONVD + RWP;
    for (int idx = part * 512 + tid; idx < 136 * PER; idx += nparts * 512) {
        const int s = idx / PER, e = idx - s * PER;
        const int last = s < 8 ? s * 2048 + 2047 : NT_P + 8 * (s - 8) + 7;
        if (e < 3 * CONVD) { const int j = e / CONVD, c = e - j * CONVD; const float v = bf1(P[(size_t)(last - 2 + j) * PP + COL_XBC + c]);
            if (s < 8) out[O_CONVP + (size_t)s * 3 * CONVD + e] = v; else out[O_CONVS + (size_t)(s - 8) * 3 * CONVD + e] = v; }
        else { const int c = e - 3 * CONVD; const float v = bf1(P[(size_t)last * PP + COL_RW + c]);
            if (s < 8) out[O_SHIFTP + (size_t)s * RWP + c] = v; else out[O_SHIFTS + (size_t)(s - 8) * RWP + c] = v; }
    }
}
__device__ __forceinline__ void mixer_task(LAS unsigned char* lds, CArgs ap, int task) {
    if (task < 128) { const int b = task >> 4, h = task & 15; rwkv_task<true>(lds, ap, h, b * 2048, 2048, nullptr, nullptr, ap->out + O_WKVP + (size_t)(b * 16 + h) * 4096); }
    else if (task < 256) { const int s = task - 128; ssd_prompt_task(lds, ap, s >> 4, s & 15); }
    else if (task < 256 + 2048) { const int s = task - 256; ssd_sample_task(lds, ap, s >> 4, s & 15); }
    else { const int s = task - 2304, b = s >> 4, h = s & 15;
        rwkv_task<false>(lds, ap, h, NT_P + 8 * b, 8, ap->in[4] + (size_t)(b * 16 + h) * 4096, ap->in[5] + (size_t)b * RWP, ap->out + O_WKVS + (size_t)(b * 16 + h) * 4096); }
}
__device__ __forceinline__ void phase_mixers(LAS unsigned char* lds) {
    const CArgs ap = get_args();
    const int nb = gridDim.x, bid = blockIdx.x;
    if (nb == 256) {
        constexpr int NRS = 0;
        mixer_task(lds, ap, bid);
        if (bid >= 128) { for (int s = bid - 128; s < 4096 - 128 * NRS; s += 128) mixer_task(lds, ap, 256 + s); copy_states(ap, bid - 128, 128); }
        else { for (int k = 0; k < NRS; ++k) mixer_task(lds, ap, 256 + 4096 - 128 * NRS + 128 * k + bid); }
    } else {
        for (int task = bid; task < 4352; task += nb) mixer_task(lds, ap, task);
        copy_states(ap, bid, nb);
    }
}
__device__ __forceinline__ void phase_final() {
    const CArgs ap = get_args();
    const int tid = get_tid(), lane = tid & 63, wave = tid >> 6;
    const int gw = blockIdx.x * 8 + wave, NGW = gridDim.x * 8;
    const float* __restrict__ hbuf = (const float*)(ap->ws + WS_H); const unsigned long long* ssq3 = (const unsigned long long*)(ap->ws + WS_SSQ3); const float* gf = ap->in[35];
    f32x4 gv[4];
#pragma unroll
    for (int j = 0; j < 4; ++j) gv[j] = *(const f32x4*)(gf + 4 * lane + 256 * j);
    for (int m = gw; m < NT; m += NGW) {
        const float rstd = rsqrtf((float)ssq3[m] * (1.0f / (1024.0f * 1048576.0f)) + 1e-6f);
#pragma unroll
        for (int j = 0; j < 4; ++j) { const f32x4 v = *(const f32x4*)(hbuf + (size_t)m * DM + 4 * lane + 256 * j); *(f32x4*)(ap->out + (size_t)m * DM + 4 * lane + 256 * j) = v * rstd * gv[j]; }
    }
}
#define XB_TMO      128
#define XB_XCNT(j)  (256  + 64 * (j))
#define XB_XSUB(j)  (1280 + 64 * (j))
#define XB_XGEN(j)  (2304 + 64 * (j))
#define XB_TOP      3328
#define XB_TOPGEN   3392
#define XCD_BAR_WORDS 3456
#define XB_SPIN_CAP (1u << 18)

__device__ __forceinline__ unsigned xb_ld(unsigned* p)              { return __hip_atomic_load(p, __ATOMIC_RELAXED, __HIP_MEMORY_SCOPE_AGENT); }
__device__ __forceinline__ unsigned xb_add(unsigned* p, unsigned v) { return __hip_atomic_fetch_add(p, v, __ATOMIC_RELAXED, __HIP_MEMORY_SCOPE_AGENT); }
__device__ __forceinline__ unsigned xb_xcc_id() { return (unsigned)__builtin_amdgcn_s_getreg((3 << 11) | 20) & 0xFu; }
#define XB_SPIN(cond, bar) do { unsigned _sp = 0; while (cond) { __builtin_amdgcn_s_sleep(1); \
    if ((++_sp & 255u) == 0u) { if (xb_ld(&(bar)[XB_TMO])) break; if (_sp > XB_SPIN_CAP) { atomicAdd(&(bar)[XB_TMO], 1u); break; } } } } while (0)

struct XcdBarrier {
    unsigned* bar; unsigned x;
    volatile LAS unsigned* st;
};

__device__ __forceinline__ XcdBarrier xcd_barrier_post(unsigned* bar, volatile LAS unsigned* st) {
    XcdBarrier b; b.bar = bar; b.x = xb_xcc_id(); b.st = st;
    if (threadIdx.x == 0) (void)xb_add(&bar[XB_XCNT(b.x)], 1u);
    return b;
}
__device__ __forceinline__ void xcd_barrier_complete(unsigned* bar, unsigned x, unsigned& nloc, unsigned& nx) {
    const unsigned G = gridDim.x * gridDim.y * gridDim.z;
    unsigned sum, cnt, mine, sp = 0u;
    for (;;) {
        sum = 0u; cnt = 0u; mine = 0u;
#pragma unroll
        for (unsigned j = 0; j < 16; ++j) { const unsigned c = xb_ld(&bar[XB_XCNT(j)]); sum += c; cnt += (c > 0u) ? 1u : 0u; mine = (j == x) ? c : mine; }
        if (sum == G) break;
        __builtin_amdgcn_s_sleep(1);
        if ((++sp & 255u) == 0u) { if (xb_ld(&bar[XB_TMO])) break; if (sp > XB_SPIN_CAP) { atomicAdd(&bar[XB_TMO], 1u); break; } }
    }
    nloc = mine > 0u ? mine : 1u; nx = cnt > 0u ? cnt : 1u;
}

__device__ __forceinline__ void xcd_barrier(const XcdBarrier& b) {
    asm volatile("s_waitcnt vmcnt(0)" ::: "memory");
    __syncthreads();
    if (threadIdx.x == 0) {
        unsigned* bar = b.bar;
        __builtin_amdgcn_s_waitcnt(0);
        unsigned nloc = b.st[0], nx = b.st[1];
        if (nloc == 0u) { xcd_barrier_complete(bar, b.x, nloc, nx); b.st[0] = nloc; b.st[1] = nx; }
        const unsigned old = xb_add(&bar[XB_XSUB(b.x)], 1u);
        const unsigned gen = old / nloc;
        if (old + 1u == (gen + 1u) * nloc) {
            __builtin_amdgcn_fence(__ATOMIC_RELEASE, "agent");
            asm volatile("s_waitcnt vmcnt(0)" ::: "memory");
            const unsigned og = xb_add(&bar[XB_TOP], 1u);
            const unsigned tg = og / nx;
            if (og + 1u == (tg + 1u) * nx) xb_add(&bar[XB_TOPGEN], 1u);
            else XB_SPIN(xb_ld(&bar[XB_TOPGEN]) == tg, bar);
            __builtin_amdgcn_fence(__ATOMIC_ACQUIRE, "agent");
            xb_add(&bar[XB_XGEN(b.x)], 1u);
            asm volatile("s_waitcnt vmcnt(0)" ::: "memory");
        } else {
            XB_SPIN(xb_ld(&bar[XB_XGEN(b.x)]) == gen, bar);
            __builtin_amdgcn_fence(__ATOMIC_ACQUIRE, "agent");
            asm volatile("s_waitcnt vmcnt(0)" ::: "memory");
        }
    }
    __syncthreads();
}


__device__ __forceinline__ void gsync(cg::grid_group& grid) {
    asm volatile("s_waitcnt vmcnt(0) lgkmcnt(0)" ::: "memory");
    grid.sync();
    __builtin_amdgcn_fence(__ATOMIC_ACQUIRE, "agent");
    asm volatile("s_waitcnt vmcnt(0)" ::: "memory");
}
__global__ void __launch_bounds__(512, 2) mega_fwd(Args a_unused) {
    extern __shared__ __attribute__((aligned(16))) unsigned char lds_raw[];
    LAS unsigned char* lds = (LAS unsigned char*)lds_raw;
    cg::grid_group grid = cg::this_grid();
    const int G = gridDim.x, bid = blockIdx.x;
    volatile LAS unsigned* xst = (volatile LAS unsigned*)(lds + 131072 + 64);
    if (threadIdx.x < 2) xst[threadIdx.x] = 0u;
    __syncthreads();
    XcdBarrier xbar = xcd_barrier_post((unsigned*)(get_args()->ws + WS_BAR), xst);
    phase0(lds);
    if (get_args()->ws == nullptr) gsync(grid);
    xcd_barrier(xbar);
    { const CArgs ap = get_args(); unsigned char* ws = ap->ws;
      pg8::Gemm g{(const bf16_t*)(ap->out + O_SSMS), (const bf16_t*)(ws + WS_WIN), NT, NW_IN, 1024}; pg8::StaticOrder S; S.init(NT, NW_IN, G, bid);
      pg8::EpiPlain E{(bf16_t*)(ws + WS_P), PP, 23, (float*)(ws + WS_DT)};
      pg8::gemm_phase<pg8::EpiPlain, pg8::StaticOrder, true, true>(lds, g, S, E); }
    xcd_barrier(xbar);
    phase_alo();
    xcd_barrier(xbar);
    phase_mixers(lds);
    xcd_barrier(xbar);
    { const CArgs ap = get_args(); unsigned char* ws = ap->ws;
      pg8::Gemm g{(const bf16_t*)ap->out, (const bf16_t*)(ws + WS_WOUT), NT, 1024, 2048}; pg8::StaticOrder S; S.init(NT, 1024, G, bid);
      pg8::EpiRes<true> E{(const unsigned long long*)(ws + WS_SSQG), ap->in[0], ap->in[1], (float*)(ws + WS_H), (bf16_t*)(ws + WS_HB), (unsigned long long*)(ws + WS_SSQ1)};
      pg8::gemm_phase<pg8::EpiRes<true>, pg8::StaticOrder, true, true>(lds, g, S, E); }
    { const int rem = ((NT / 256) * 4) % G; phase0b(lds, (G >= 64 && rem > 0 && rem < G - 32) ? rem : 0); }
    xcd_barrier(xbar);
    { const CArgs ap = get_args(); unsigned char* ws = ap->ws;
      pg8::Gemm g{(const bf16_t*)(ws + WS_HB), (const bf16_t*)(ws + WS_WGU), NT, 2 * DFF, 1024}; pg8::StaticOrder S; S.init(NT, 2 * DFF, G, bid);
      pg8::EpiGU E{(bf16_t*)(ws + WS_FF), (const unsigned long long*)(ws + WS_SSQ1)};
      pg8::gemm_phase<pg8::EpiGU, pg8::StaticOrder, true, true>(lds, g, S, E); }
    xcd_barrier(xbar);
    { const CArgs ap = get_args(); unsigned char* ws = ap->ws; float* hbuf = (float*)(ws + WS_H);
      pg8::Gemm g{(const bf16_t*)(ws + WS_FF), (const bf16_t*)(ws + WS_WDOWN), NT, 1024, DFF}; pg8::StaticOrder S; S.init(NT, 1024, G, bid);
      pg8::EpiRes<false> E{nullptr, hbuf, hbuf + (size_t)NT_P * 1024, hbuf, (bf16_t*)(ws + WS_HB), (unsigned long long*)(ws + WS_SSQ2)};
      pg8::gemm_phase<pg8::EpiRes<false>, pg8::StaticOrder, true, true>(lds, g, S, E); }
    { const int rem_ = ((NT / 256) * 4) % G; const int ppf = (G >= 64 && rem_ > 0 && rem_ < G - 32) ? rem_ : 0;
      if (bid >= ppf) { const CArgs ap = get_args(); unsigned char* ws = ap->ws;
      pg8::Gemm g{(const bf16_t*)(ws + WS_PB), (const bf16_t*)(ws + WS_WPLP), NT, 1024, 256}; pg8::StaticOrder S; S.init(NT, 1024, G - ppf, bid - ppf);
      pg8::EpiPlain E{(bf16_t*)ap->out, 1024, 4, nullptr};
      pg8::gemm_phase<pg8::EpiPlain, pg8::StaticOrder, true, true>(lds, g, S, E); } }
    xcd_barrier(xbar);
    { const CArgs ap = get_args(); unsigned char* ws = ap->ws;
      pg8::Gemm g{(const bf16_t*)(ws + WS_HB), (const bf16_t*)(ws + WS_WPLG), NT, 1024, 1024}; pg8::StaticOrder S; S.init(NT, 1024, G, bid);
      pg8::EpiPle E{(float*)(ws + WS_H), (const bf16_t*)ap->out, (const unsigned long long*)(ws + WS_SSQ2), (unsigned long long*)(ws + WS_SSQ3)};
      pg8::gemm_phase<pg8::EpiPle, pg8::StaticOrder, true, true>(lds, g, S, E); }
    xcd_barrier(xbar);
    phase_final();
}

extern "C" void kernel_launch(void* const* d_in, const int* in_sizes, int n_in, void* d_out, int out_size, void* d_ws, size_t ws_size, hipStream_t stream) {
    static int grid_blocks = 0;
    if (grid_blocks == 0) {
        if (n_in != 36 || out_size != (int)O_END || ws_size < 256 * MiB) { fprintf(stderr, "kernel_launch: unexpected problem shape (n_in %d out %d ws %zu)\n", n_in, out_size, ws_size); grid_blocks = -1; return; }
        int dev = 0, cus = 0, per_cu = 0;
        hipGetDevice(&dev);
        hipDeviceGetAttribute(&cus, hipDeviceAttributeMultiprocessorCount, dev);
        if (hipFuncSetAttribute((const void*)mega_fwd, hipFuncAttributeMaxDynamicSharedMemorySize, LDS_BYTES) != hipSuccess) { fprintf(stderr, "kernel_launch: hipFuncSetAttribute failed\n"); grid_blocks = -1; return; }
        if (hipOccupancyMaxActiveBlocksPerMultiprocessor(&per_cu, (const void*)mega_fwd, 512, LDS_BYTES) != hipSuccess || per_cu < 1) per_cu = 1;
        (void)hipGetLastError();
        grid_blocks = cus * per_cu;
    }
    if (grid_blocks < 0) return;
    hipMemsetAsync(d_ws, 0, WS_ZERO_BYTES, stream);
    Args a{};
    for (int i = 0; i < 36; ++i) a.in[i] = (const float*)d_in[i];
    a.out = (float*)d_out; a.ws = (unsigned char*)d_ws;
    void* args[] = {&a};
    hipError_t e = hipLaunchCooperativeKernel((const void*)mega_fwd, dim3(grid_blocks), dim3(512), args, LDS_BYTES, stream);
    if (e != hipSuccess) fprintf(stderr, "cooperative launch failed: %s (grid %d)\n", hipGetErrorString(e), grid_blocks);
}
```
